# Optimizing an MI355X kernel written in HIP

```python
import math
import jax, jax.numpy as jnp
from jax import lax
import numpy as np

D_MODEL = 1024
BATCH = 8
SEQ = 2048
DEPTH = 1
DEC_BATCH = 128
DEC_SEQ = 8
PAST_LEN = 16384
PAGE_SIZE = 128

MIX_WIDTH = D_MODEL
RET_WIDTH = MIX_WIDTH // 2
RET_HEADS = 4
RET_HD = RET_WIDTH // RET_HEADS
CONV_WIDTH = MIX_WIDTH - RET_WIDTH
CONV_GROUPS = 4
CONV_K = 3
RET_CHUNK = 128
ROPE_BASE = 10000.0
D_FF = ((8 * D_MODEL + 3 * 256 - 1) // (3 * 256)) * 256
IN_COLS = 4 * RET_WIDTH + 3 * CONV_WIDTH
NORM_EPS = 1e-6
GN_EPS = 1e-5

kernel_name = "retnet_shortconv_hybrid_step"


def rmsnorm(x, g):
    x32 = x.astype(jnp.float32)
    y = x32 * lax.rsqrt(jnp.mean(x32 * x32, axis=-1, keepdims=True) + NORM_EPS)
    return (y * g.astype(jnp.float32)).astype(x.dtype)


def rotary(t, pos):
    half = t.shape[-1] // 2
    inv = ROPE_BASE ** (-jnp.arange(half, dtype=jnp.float32) / half)
    ang = pos[:, None] * inv[None, :]
    cos = jnp.cos(ang)[None, :, None, :]
    sin = jnp.sin(ang)[None, :, None, :]
    t32 = t.astype(jnp.float32)
    t1, t2 = t32[..., :half], t32[..., half:]
    return jnp.concatenate([t1 * cos - t2 * sin, t1 * sin + t2 * cos], axis=-1)


def retention_chunkwise(q, k, v, state0):
    B, L, H, D = q.shape
    C = math.gcd(L, RET_CHUNK)
    n = L // C
    log_g = jnp.log1p(-jnp.exp2(-5.0 - jnp.arange(H, dtype=jnp.float32)))
    idx = jnp.arange(C, dtype=jnp.float32)
    diff = idx[:, None] - idx[None, :]
    causal = diff >= 0
    decay = jnp.where(causal[None], jnp.exp(jnp.where(causal, diff, 0.0)[None] * log_g[:, None, None]), 0.0)
    xi = jnp.exp((idx[None, :] + 1.0) * log_g[:, None])
    zeta = jnp.exp((C - 1.0 - idx[None, :]) * log_g[:, None])
    g_chunk = jnp.exp(C * log_g)

    def to_chunks(t):
        return t.reshape(B, n, C, H, D).transpose(1, 0, 3, 2, 4)

    def step(R, xs):
        qc, kc, vc = xs
        scores = jnp.einsum('bhid,bhjd->bhij', qc, kc) * decay[None]
        o = jnp.einsum('bhij,bhjv->bhiv', scores, vc)
        o = o + jnp.einsum('bhid,bhdv->bhiv', qc, R) * xi[None, :, :, None]
        R_new = R * g_chunk[None, :, None, None] + jnp.einsum(
            'bhjd,bhjv->bhdv', kc * zeta[None, :, :, None], vc)
        return R_new, o

    R_fin, o = lax.scan(step, state0, (to_chunks(q), to_chunks(k), to_chunks(v)))
    o = o.transpose(1, 0, 3, 2, 4).reshape(B, L, H, D)
    return o, R_fin


def layer(x, conv_state, ret_state, pos0, norm1_g, w_in, conv_w, ret_gn_g, w_out,
          norm2_g, w_gate, w_up, w_down):
    B, L, _ = x.shape
    h = rmsnorm(x, norm1_g)
    proj = h @ w_in
    splits = np.cumsum([RET_WIDTH] * 4 + [CONV_WIDTH] * 2).tolist()
    q, k, v, g, bg, cg, xt = jnp.split(proj, splits, axis=-1)

    pos = pos0 + jnp.arange(L, dtype=jnp.float32)
    qh = rotary(q.reshape(B, L, RET_HEADS, RET_HD), pos)
    kh = rotary(k.reshape(B, L, RET_HEADS, RET_HD), pos) * (RET_HD ** -0.5)
    vh = v.reshape(B, L, RET_HEADS, RET_HD).astype(jnp.float32)
    o, R_new = retention_chunkwise(qh, kh, vh, ret_state.astype(jnp.float32))
    mu = jnp.mean(o, axis=-1, keepdims=True)
    var = jnp.mean(jnp.square(o - mu), axis=-1, keepdims=True)
    o = ((o - mu) * lax.rsqrt(var + GN_EPS)).reshape(B, L, RET_WIDTH) * ret_gn_g.astype(jnp.float32)
    o_ret = (jax.nn.silu(g.astype(jnp.float32)) * o).astype(x.dtype)

    u = cg * xt
    ext = jnp.concatenate([conv_state.astype(u.dtype), u], axis=1)
    conv_y = sum(conv_w[j] * ext[:, j:j + L] for j in range(CONV_K))
    conv_new = ext[:, L:]
    o_conv = bg * conv_y

    x = x + jnp.concatenate([o_ret, o_conv.astype(x.dtype)], axis=-1) @ w_out

    h2 = rmsnorm(x, norm2_g)
    x = x + (jax.nn.silu(h2 @ w_gate) * (h2 @ w_up)) @ w_down
    return x, conv_new, R_new


def setup_inputs(seed: int = 0) -> dict:
    key = jax.random.key(seed)
    ks = jax.random.split(key, 16)
    f32 = jnp.float32
    nrm = lambda k, s, sc: jax.random.normal(k, s, f32) * sc
    return {
        "x_prompt": nrm(ks[0], (BATCH, SEQ, D_MODEL), 1.0),
        "x_sample": nrm(ks[1], (DEC_BATCH, DEC_SEQ, D_MODEL), 1.0),
        "state_conv": nrm(ks[2], (DEPTH, DEC_BATCH, CONV_K - 1, CONV_WIDTH), 1.0),
        "state_ret": nrm(ks[3], (DEPTH, DEC_BATCH, RET_HEADS, RET_HD, RET_HD), 0.5),
        "norm1_g": 1.0 + nrm(ks[4], (DEPTH, D_MODEL), 0.01),
        "w_in": nrm(ks[5], (DEPTH, D_MODEL, IN_COLS), D_MODEL ** -0.5),
        "conv_w": nrm(ks[6], (DEPTH, CONV_K, CONV_WIDTH), 0.5),
        "ret_gn_g": 1.0 + nrm(ks[7], (DEPTH, RET_WIDTH), 0.01),
        "w_out": nrm(ks[8], (DEPTH, MIX_WIDTH, D_MODEL), MIX_WIDTH ** -0.5),
        "norm2_g": 1.0 + nrm(ks[9], (DEPTH, D_MODEL), 0.01),
        "w_gate": nrm(ks[10], (DEPTH, D_MODEL, D_FF), D_MODEL ** -0.5),
        "w_up": nrm(ks[11], (DEPTH, D_MODEL, D_FF), D_MODEL ** -0.5),
        "w_down": nrm(ks[12], (DEPTH, D_FF, D_MODEL), D_FF ** -0.5),
        "norm_f_g": 1.0 + nrm(ks[13], (D_MODEL,), 0.01),
    }


def reference(x_prompt, x_sample, state_conv, state_ret, norm1_g, w_in, conv_w, ret_gn_g,
              w_out, norm2_g, w_gate, w_up, w_down, norm_f_g):
    hp, hs = x_prompt, x_sample
    cp_list, rp_list, cs_list, rs_list = [], [], [], []
    for l in range(DEPTH):
        params = (norm1_g[l], w_in[l], conv_w[l], ret_gn_g[l], w_out[l],
                  norm2_g[l], w_gate[l], w_up[l], w_down[l])
        conv0 = jnp.zeros((BATCH, CONV_K - 1, CONV_WIDTH), x_prompt.dtype)
        ret0 = jnp.zeros((BATCH, RET_HEADS, RET_HD, RET_HD), jnp.float32)
        hp, cp, rp = layer(hp, conv0, ret0, 0.0, *params)
        hs, cs, rs = layer(hs, state_conv[l], state_ret[l], float(PAST_LEN), *params)
        cp_list.append(cp); rp_list.append(rp); cs_list.append(cs); rs_list.append(rs)
    y_prompt = rmsnorm(hp, norm_f_g)
    y_sample = rmsnorm(hs, norm_f_g)
    new_conv_prompt = jnp.stack(cp_list)
    new_ret_prompt = jnp.stack(rp_list)
    new_conv_sample = jnp.stack(cs_list)
    new_ret_sample = jnp.stack(rs_list)
    return (y_prompt, y_sample, new_conv_prompt, new_ret_prompt, new_conv_sample, new_ret_sample)
```

```cpp
#include <hip/hip_runtime.h>
#include <hip/hip_cooperative_groups.h>
#include <cstdio>
#include <cstdint>
namespace cg = cooperative_groups;
#define MK_N_LAUNCHES 1
namespace pg8 {
#define PG8_LAS __attribute__((address_space(3)))
typedef unsigned short bf16_t;
typedef short bf16x8 __attribute__((ext_vector_type(8)));
typedef float f32x4 __attribute__((ext_vector_type(4)));
typedef unsigned u32x4 __attribute__((ext_vector_type(4)));
constexpr int BM = 256, BK = 64, HALF = 128, HTB = HALF * BK * 2  , STAGE_BYTES = 8 * HTB, NXCD = 8, WGM = 8;

__host__ __device__ __forceinline__ int lds_byte(int r, int c) { const int st = (r >> 4) * 2 + (c >> 5), rr = r & 15, cc = c & 31, ob = rr * 64 + cc * 2; return st * 1024 + (ob ^ (((ob >> 9) & 1) << 5)); }
__host__ __device__ __forceinline__ void stage_rc(int b, int& R, int& C) { const int st = b / 1024, sb = b % 1024, swz = sb ^ (((sb >> 9) & 1) << 5); R = (st >> 1) * 16 + swz / 64; C = (st & 1) * 32 + (swz % 64) / 2; }
__host__ __device__ __forceinline__ int perm32(int rho) { const int n = rho >> 4, i = rho & 15; return 8 * (i >> 2) + 4 * n + (i & 3); }

struct Unit { int pm, pn; };
struct Gemm { const bf16_t* A; const bf16_t* Bt; int M, N, K; };

struct StaticOrder {
    int nM, nN, nwg, G, c;
    __host__ __device__ void init(int M, int N, int G_, int c_) { nM = M / BM; nN = N / BM; nwg = nM * nN; G = G_; c = c_; }
    __host__ __device__ bool next(int i, Unit& u) const {
        const long L = (long)i * G + c; if (L >= nwg) return false;
        int wgid = (int)L; { const int q = nwg / NXCD, r = nwg % NXCD, xcd = wgid % NXCD, off = wgid / NXCD; wgid = (xcd < r ? xcd * (q + 1) : r * (q + 1) + (xcd - r) * q) + off; }
        const int nig = WGM * nN, gid = wgid / nig, fm = gid * WGM, gsz = (nM - fm) < WGM ? (nM - fm) : WGM;
        u.pm = fm + ((wgid % nig) % gsz); u.pn = (wgid % nig) / gsz; return true;
    }
    __device__ __forceinline__ void a_ready(const Unit&) const {}
    __device__ __forceinline__ void done(const Unit&) const {}
};

__device__ __forceinline__ unsigned cvt_pk_bf16(float lo, float hi) { unsigned r; asm volatile("v_cvt_pk_bf16_f32 %0, %1, %2" : "=v"(r) : "v"(lo), "v"(hi)); return r; }
template <class Epi, class Sched, bool ALIGN_EPI = false, bool SP2 = false>
__device__ __forceinline__ void gemm_phase(PG8_LAS unsigned char* lds, const Gemm g, const Sched& S, const Epi& E) {
    const int tid = threadIdx.x, wid = __builtin_amdgcn_readfirstlane(tid >> 6), lane = tid & 63, wr = wid >> 2, wc = wid & 3, fr = lane & 15, fq = lane >> 4;
    const int K = g.K, nt = K / BK;
    unsigned voffA[2], voffB[2];
#pragma unroll
    for (int i = 0; i < 2; ++i) { int R, C; stage_rc(tid * 16 + i * 8192, R, C); const int Rb = Epi::PERM ? ((R & ~31) + perm32(R & 31)) : R;
        voffA[i] = (unsigned)(R * K + C) * 2u; voffB[i] = (unsigned)(Rb * K + C) * 2u; }
    const size_t kstep = (size_t)(BK * 2);
    const size_t hstep = (size_t)HALF * K * 2;
    const size_t tstep = 2 * hstep;
    const unsigned ldsw = (unsigned)wid * 1024u;
    const int aoff = lds_byte(wr * 64 + fr, fq * 8), boff = lds_byte(wc * 32 + fr, fq * 8);
#define PG8_SA(b, h) (((b) * 2 + (h)) * HTB)
#define PG8_SB(b, h) ((4 + (b) * 2 + (h)) * HTB)
#define PG8_STAGE(bufoff, gbase, voff) do { _Pragma("unroll") for (int _i = 0; _i < 2; ++_i) \
        __builtin_amdgcn_global_load_lds((const unsigned*)((const char*)(gbase) + (voff)[_i]), (PG8_LAS unsigned*)(lds + (bufoff) + ldsw + _i * 8192), 16, 0, 0); } while (0)
#define PG8_LDA(dst, b, h) do { _Pragma("unroll") for (int m = 0; m < 4; ++m) _Pragma("unroll") for (int k = 0; k < 2; ++k) dst[m][k] = *(const PG8_LAS bf16x8*)(lds + PG8_SA(b, h) + aoff + m * 2048 + k * 1024); } while (0)
#define PG8_LDB(dst, b, h) do { _Pragma("unroll") for (int n = 0; n < 2; ++n) _Pragma("unroll") for (int k = 0; k < 2; ++k) dst[n][k] = *(const PG8_LAS bf16x8*)(lds + PG8_SB(b, h) + boff + n * 2048 + k * 1024); } while (0)
#define PG8_MMA(ai, bj, At, Bt) do { __builtin_amdgcn_s_setprio(1); _Pragma("unroll") for (int m = 0; m < 4; ++m) _Pragma("unroll") for (int n = 0; n < 2; ++n) _Pragma("unroll") for (int k = 0; k < 2; ++k) \
        acc[ai][bj][m][n] = __builtin_amdgcn_mfma_f32_16x16x32_bf16(Bt[n][k], At[m][k], acc[ai][bj][m][n], 0, 0, 0); __builtin_amdgcn_s_setprio(0); } while (0)
#define PG8_WAIT_V(n) asm volatile("s_waitcnt vmcnt(" #n ")" ::: "memory")
#define PG8_WAIT_L(n) asm volatile("s_waitcnt lgkmcnt(" #n ")" ::: "memory")
#define PG8_BAR __builtin_amdgcn_s_barrier()
#define PG8_SCHED __builtin_amdgcn_sched_barrier(0)
    Unit cur, nxt; int ui = 0;
    if (!S.next(0, cur)) return;
    f32x4 acc[2][2][4][2];
#pragma unroll
    for (int a = 0; a < 2; ++a)
#pragma unroll
        for (int b = 0; b < 2; ++b)
#pragma unroll
            for (int m = 0; m < 4; ++m)
#pragma unroll
                for (int n = 0; n < 2; ++n) acc[a][b][m][n] = (f32x4){0.f, 0.f, 0.f, 0.f};
    bf16x8 At[4][2], B0[2][2], B1[2][2];
    const char* cA = (const char*)g.A + (size_t)cur.pm * tstep; const char* cB = (const char*)g.Bt + (size_t)cur.pn * tstep;
    S.a_ready(cur);
    if constexpr (SP2) {
        PG8_STAGE(PG8_SB(0, 0), cB, voffB); PG8_STAGE(PG8_SB(0, 1), cB + hstep, voffB); PG8_STAGE(PG8_SA(0, 0), cA, voffA); PG8_STAGE(PG8_SA(0, 1), cA + hstep, voffA);
        if (wr == 1) PG8_BAR;
        PG8_WAIT_V(2); PG8_BAR;
        PG8_STAGE(PG8_SB(1, 0), cB + kstep, voffB); PG8_STAGE(PG8_SA(1, 0), cA + kstep, voffA); PG8_STAGE(PG8_SB(1, 1), cB + hstep + kstep, voffB);
        PG8_WAIT_V(6); PG8_BAR;
    } else {
        PG8_STAGE(PG8_SB(0, 0), cB, voffB); PG8_STAGE(PG8_SA(0, 0), cA, voffA); PG8_STAGE(PG8_SB(0, 1), cB + hstep, voffB); PG8_STAGE(PG8_SA(0, 1), cA + hstep, voffA);
        if (wr == 1) PG8_BAR;
        PG8_WAIT_V(4); PG8_BAR;
        PG8_STAGE(PG8_SB(1, 0), cB + kstep, voffB); PG8_STAGE(PG8_SA(1, 0), cA + kstep, voffA); PG8_STAGE(PG8_SB(1, 1), cB + hstep + kstep, voffB);
        PG8_WAIT_V(6); PG8_BAR;
    }
    for (;;) {
        const bool has_next = S.next(ui + 1, nxt);
        const char* nA = has_next ? (const char*)g.A + (size_t)nxt.pm * tstep : cA; const char* nB = has_next ? (const char*)g.Bt + (size_t)nxt.pn * tstep : cB;
        for (int t = 0; t < nt; t += 2) {
            const bool last = (t == nt - 2);
            const char* a1 = cA + (size_t)(t + 1) * kstep;
            const char* a2 = last ? nA : cA + (size_t)(t + 2) * kstep; const char* b2 = last ? nB : cB + (size_t)(t + 2) * kstep;
            const char* a3 = a2 + kstep; const char* b3 = b2 + kstep;
            if (last && has_next) S.a_ready(nxt);
            if constexpr (SP2) {
            PG8_LDB(B0, 0, 0); PG8_LDB(B1, 0, 1); PG8_SCHED; PG8_LDA(At, 0, 0); PG8_STAGE(PG8_SA(1, 1), a1 + hstep, voffA);
            PG8_WAIT_V(8); PG8_WAIT_L(0); PG8_BAR; PG8_MMA(0, 0, At, B0); PG8_MMA(0, 1, At, B1); PG8_BAR; PG8_SCHED;
            PG8_LDA(At, 0, 1); PG8_STAGE(PG8_SB(0, 0), b2, voffB); PG8_STAGE(PG8_SB(0, 1), b2 + hstep, voffB); PG8_STAGE(PG8_SA(0, 0), a2, voffA);
            PG8_WAIT_V(8); PG8_WAIT_L(0); PG8_BAR; PG8_MMA(1, 0, At, B0); PG8_MMA(1, 1, At, B1); PG8_BAR; PG8_SCHED;
            PG8_LDB(B0, 1, 0); PG8_LDB(B1, 1, 1); PG8_SCHED; PG8_LDA(At, 1, 0); PG8_STAGE(PG8_SA(0, 1), a2 + hstep, voffA);
            PG8_WAIT_V(8); PG8_WAIT_L(0); PG8_BAR; PG8_MMA(0, 0, At, B0); PG8_MMA(0, 1, At, B1); PG8_BAR; PG8_SCHED;
            PG8_LDA(At, 1, 1); PG8_STAGE(PG8_SB(1, 0), b3, voffB); PG8_STAGE(PG8_SB(1, 1), b3 + hstep, voffB); PG8_STAGE(PG8_SA(1, 0), a3, voffA);
            PG8_WAIT_V(8); PG8_WAIT_L(0); PG8_BAR; PG8_MMA(1, 0, At, B0); PG8_MMA(1, 1, At, B1); PG8_BAR; PG8_SCHED;
            } else {
            PG8_LDB(B0, 0, 0); PG8_SCHED; PG8_LDA(At, 0, 0); PG8_STAGE(PG8_SA(1, 1), a1 + hstep, voffA);
            PG8_WAIT_L(8); PG8_BAR; PG8_WAIT_L(0); PG8_MMA(0, 0, At, B0); PG8_BAR; PG8_SCHED;
            PG8_LDB(B1, 0, 1); PG8_STAGE(PG8_SB(0, 0), b2, voffB);
            PG8_BAR; PG8_WAIT_L(0); PG8_MMA(0, 1, At, B1); PG8_BAR;
            PG8_LDA(At, 0, 1); PG8_STAGE(PG8_SA(0, 0), a2, voffA);
            PG8_BAR; PG8_WAIT_L(0); PG8_MMA(1, 0, At, B0); PG8_BAR; PG8_SCHED;
            PG8_STAGE(PG8_SB(0, 1), b2 + hstep, voffB);
            PG8_WAIT_V(6); PG8_BAR; PG8_MMA(1, 1, At, B1); PG8_BAR;
            PG8_LDB(B0, 1, 0); PG8_SCHED; PG8_LDA(At, 1, 0); PG8_STAGE(PG8_SA(0, 1), a2 + hstep, voffA);
            PG8_WAIT_L(8); PG8_BAR; PG8_WAIT_L(0); PG8_MMA(0, 0, At, B0); PG8_BAR; PG8_SCHED;
            PG8_LDB(B1, 1, 1); PG8_STAGE(PG8_SB(1, 0), b3, voffB);
            PG8_BAR; PG8_WAIT_L(0); PG8_MMA(0, 1, At, B1); PG8_BAR;
            PG8_LDA(At, 1, 1); PG8_STAGE(PG8_SA(1, 0), a3, voffA);
            PG8_BAR; PG8_WAIT_L(0); PG8_MMA(1, 0, At, B0); PG8_BAR; PG8_SCHED;
            PG8_STAGE(PG8_SB(1, 1), b3 + hstep, voffB);
            PG8_WAIT_V(6); PG8_BAR; PG8_MMA(1, 1, At, B1); PG8_BAR;
            }
        }
        if constexpr (ALIGN_EPI) { if (wr == 0) PG8_BAR; }
        if constexpr (!Epi::AFTER_DRAIN) { E(acc, cur, wr, wc, fr, fq); S.done(cur); }
        if (!has_next) break;
#pragma unroll
        for (int a = 0; a < 2; ++a)
#pragma unroll
            for (int b = 0; b < 2; ++b)
#pragma unroll
                for (int m = 0; m < 4; ++m)
#pragma unroll
                    for (int n = 0; n < 2; ++n) acc[a][b][m][n] = (f32x4){0.f, 0.f, 0.f, 0.f};
        cur = nxt; cA = nA; cB = nB; ++ui;
        if constexpr (ALIGN_EPI) { if (wr == 1) PG8_BAR; }
    }
    PG8_WAIT_V(0);
    if constexpr (!ALIGN_EPI) { if (wr == 0) PG8_BAR; }
    PG8_BAR;
    if constexpr (Epi::AFTER_DRAIN) { E.fused(acc, cur, wr, wc, fr, fq, lds, wid, lane); S.done(cur); }
#undef PG8_SA
#undef PG8_SB
#undef PG8_STAGE
#undef PG8_LDA
#undef PG8_LDB
#undef PG8_MMA
#undef PG8_WAIT_V
#undef PG8_WAIT_L
#undef PG8_BAR
#undef PG8_SCHED
}
}

#ifndef MK_N_LAUNCHES
#define MK_N_LAUNCHES 1
#endif
constexpr int DM = 1024, NPROMPT = 16384, M = 17408, SEQ = 2048;
constexpr int NIN = 3584, PROJW = 3072, FF = 2816, NGU = 5632;
constexpr int NPHASE = 9;
constexpr int NWAVES = 8;
constexpr size_t MiB = 1u << 20;
constexpr size_t WS_WIN = 0, WS_WOUT = 7 * MiB, WS_WGU = 9 * MiB, WS_WDN = 20 * MiB, WS_CS = 26 * MiB, WS_SS2 = 28 * MiB;
constexpr size_t WS_XN = 30 * MiB;
constexpr size_t WS_PROJ = 64 * MiB;
constexpr size_t WS_KV = 166 * MiB;
constexpr size_t WS_RS = 198 * MiB;
constexpr size_t WS_MIX = 214 * MiB;
constexpr size_t WS_END = 248 * MiB;
constexpr int LDS_BYTES = 147456;
constexpr size_t OUT_Y = 0, OUT_NCP = (size_t)M * DM, OUT_NRP = OUT_NCP + 8192, OUT_NCS = OUT_NRP + 524288, OUT_NRS = OUT_NCS + 131072;

#define GAS __attribute__((address_space(1)))
#define LAS __attribute__((address_space(3)))
typedef unsigned short bf16;
typedef unsigned v4u __attribute__((ext_vector_type(4)));
typedef unsigned v2u __attribute__((ext_vector_type(2)));
typedef float f32x4 __attribute__((ext_vector_type(4)));
typedef short bf16x8 __attribute__((ext_vector_type(8)));
typedef short s16x4 __attribute__((ext_vector_type(4)));
using pg8::cvt_pk_bf16;
#define LDS_WAIT() asm volatile("s_waitcnt lgkmcnt(0)" ::: "memory")

__device__ __forceinline__ float bf2f(unsigned h) { return __builtin_bit_cast(float, h << 16); }
__device__ __forceinline__ float bflo(unsigned w) { return __builtin_bit_cast(float, w << 16); }
__device__ __forceinline__ float bfhi(unsigned w) { return __builtin_bit_cast(float, w & 0xffff0000u); }
__device__ __forceinline__ v4u pack8(f32x4 a, f32x4 b) { v4u w; w.x = cvt_pk_bf16(a[0], a[1]); w.y = cvt_pk_bf16(a[2], a[3]); w.z = cvt_pk_bf16(b[0], b[1]); w.w = cvt_pk_bf16(b[2], b[3]); return w; }
__device__ __forceinline__ void unpack8(v4u w, f32x4& a, f32x4& b) { a = (f32x4){bflo(w.x), bfhi(w.x), bflo(w.y), bfhi(w.y)}; b = (f32x4){bflo(w.z), bfhi(w.z), bflo(w.w), bfhi(w.w)}; }
__device__ __forceinline__ float wave_sum(float v) {
#pragma unroll
    for (int o = 1; o < 64; o <<= 1) v += __shfl_xor(v, o);
    return v;
}
__device__ __forceinline__ float silu_f(float x) { return x * __builtin_amdgcn_rcpf(1.0f + __builtin_amdgcn_exp2f(-1.4426950408889634f * x)); }
__device__ __forceinline__ float log2_gamma(int h) { return log2f(1.0f - exp2f(-5.0f - (float)h)); }

struct EpiInProj {
    static constexpr bool PERM = true, AFTER_DRAIN = false;
    bf16* P; const float* cs;
    __device__ __forceinline__ void operator()(const f32x4 (&acc)[2][2][4][2], const pg8::Unit& u, int wr, int wc, int fr, int fq) const {
        const int pn = u.pn, cgp = wc * 32 + 8 * fq, rowb = u.pm * 256 + wr * 64 + fr;
        if (pn < 4) {
            const int sec = pn >> 1, head = 2 * (pn & 1) + (cgp >> 6), dd = cgp & 63;
            const float sc = sec ? 0.08838834764831845f : 1.0f;
            const int oc = sec * 512 + head * 128 + dd;
#pragma unroll
            for (int ai = 0; ai < 2; ++ai)
#pragma unroll
                for (int m = 0; m < 4; ++m) {
                    const int row = rowb + ai * 128 + m * 16;
                    const int pidx = row < NPROMPT ? (row & (SEQ - 1)) : SEQ + (row & 7);
                    const float* t = cs + (size_t)pidx * 128 + dd;
                    const f32x4 c0 = *(const f32x4*)t, c1 = *(const f32x4*)(t + 4), s0 = *(const f32x4*)(t + 64), s1 = *(const f32x4*)(t + 68);
                    const f32x4 a0 = acc[ai][0][m][0], a1 = acc[ai][0][m][1], b0 = acc[ai][1][m][0], b1 = acc[ai][1][m][1];
                    bf16* o = P + (size_t)row * PROJW + oc;
                    *(v4u*)o = pack8((a0 * c0 - b0 * s0) * sc, (a1 * c1 - b1 * s1) * sc);
                    *(v4u*)(o + 64) = pack8((a0 * s0 + b0 * c0) * sc, (a1 * s1 + b1 * c1) * sc);
                }
        } else if (pn < 10) {
#pragma unroll
            for (int ai = 0; ai < 2; ++ai)
#pragma unroll
                for (int m = 0; m < 4; ++m) {
                    const int row = rowb + ai * 128 + m * 16;
                    bf16* o = P + (size_t)row * PROJW + pn * 256 + cgp;
                    *(v4u*)o = pack8(acc[ai][0][m][0], acc[ai][0][m][1]);
                    *(v4u*)(o + 128) = pack8(acc[ai][1][m][0], acc[ai][1][m][1]);
                }
        } else {
#pragma unroll
            for (int ai = 0; ai < 2; ++ai)
#pragma unroll
                for (int m = 0; m < 4; ++m) {
                    const int row = rowb + ai * 128 + m * 16;
                    bf16* o = P + (size_t)row * PROJW + 2560 + (pn - 10) * 128 + cgp;
                    *(v4u*)o = pack8(acc[ai][0][m][0] * acc[ai][1][m][0], acc[ai][0][m][1] * acc[ai][1][m][1]);
                }
        }
    }
};
struct EpiOut {
    static constexpr bool PERM = true, AFTER_DRAIN = false;
    const float* xp; const float* xs; float* x1; bf16* h2; const float* g2; float* ss2;
    __device__ __forceinline__ void operator()(const f32x4 (&acc)[2][2][4][2], const pg8::Unit& u, int wr, int wc, int fr, int fq) const {
        const int cgp = wc * 32 + 8 * fq, rowb = u.pm * 256 + wr * 64 + fr;
#pragma unroll
        for (int ai = 0; ai < 2; ++ai)
#pragma unroll
            for (int m = 0; m < 4; ++m) {
                const int row = rowb + ai * 128 + m * 16;
                const float* xr = row < NPROMPT ? xp + (size_t)row * DM : xs + (size_t)(row - NPROMPT) * DM;
                float ss = 0.f;
#pragma unroll
                for (int bj = 0; bj < 2; ++bj) {
                    const int col = u.pn * 256 + bj * 128 + cgp;
                    const f32x4 v0 = acc[ai][bj][m][0] + *(const f32x4*)(xr + col), v1 = acc[ai][bj][m][1] + *(const f32x4*)(xr + col + 4);
                    float* o = x1 + (size_t)row * DM + col;
                    *(f32x4*)o = v0; *(f32x4*)(o + 4) = v1;
                    ss += (v0[0] * v0[0] + v0[1] * v0[1]) + (v0[2] * v0[2] + v0[3] * v0[3]) + (v1[0] * v1[0] + v1[1] * v1[1]) + (v1[2] * v1[2] + v1[3] * v1[3]);
                    const f32x4 g0 = *(const f32x4*)(g2 + col), g1 = *(const f32x4*)(g2 + col + 4);
                    *(v4u*)(h2 + (size_t)row * DM + col) = pack8(v0 * g0, v1 * g1);
                }
                ss += __shfl_xor(ss, 16); ss += __shfl_xor(ss, 32);
                if (fq == 0) ss2[(size_t)row * 16 + u.pn * 4 + wc] = ss;
            }
    }
};
struct EpiGU {
    static constexpr bool PERM = true, AFTER_DRAIN = false;
    const float* ss2; bf16* act;
    __device__ __forceinline__ void operator()(const f32x4 (&acc)[2][2][4][2], const pg8::Unit& u, int wr, int wc, int fr, int fq) const {
        const int cgp = wc * 32 + 8 * fq, rowb = u.pm * 256 + wr * 64 + fr;
#pragma unroll
        for (int ai = 0; ai < 2; ++ai)
#pragma unroll
            for (int m = 0; m < 4; ++m) {
                const int row = rowb + ai * 128 + m * 16;
                const f32x4* sp = (const f32x4*)(ss2 + (size_t)row * 16);
                const f32x4 p0 = sp[0], p1 = sp[1], p2 = sp[2], p3 = sp[3];
                const f32x4 ps = (p0 + p1) + (p2 + p3);
                const float r = rsqrtf(((ps[0] + ps[1]) + (ps[2] + ps[3])) * (1.0f / DM) + 1e-6f);
                f32x4 o[2];
#pragma unroll
                for (int n = 0; n < 2; ++n) {
                    const f32x4 g = acc[ai][0][m][n] * r, up = acc[ai][1][m][n] * r;
                    o[n] = (f32x4){silu_f(g[0]) * up[0], silu_f(g[1]) * up[1], silu_f(g[2]) * up[2], silu_f(g[3]) * up[3]};
                }
                *(v4u*)(act + (size_t)row * FF + u.pn * 128 + cgp) = pack8(o[0], o[1]);
            }
    }
};
struct EpiDown {
    static constexpr bool PERM = true, AFTER_DRAIN = false;
    float* io;
    __device__ __forceinline__ void operator()(const f32x4 (&acc)[2][2][4][2], const pg8::Unit& u, int wr, int wc, int fr, int fq) const {
        const int cgp = wc * 32 + 8 * fq, rowb = u.pm * 256 + wr * 64 + fr;
#pragma unroll
        for (int ai = 0; ai < 2; ++ai)
#pragma unroll
            for (int m = 0; m < 4; ++m) {
                const int row = rowb + ai * 128 + m * 16;
#pragma unroll
                for (int bj = 0; bj < 2; ++bj) {
                    float* o = io + (size_t)row * DM + u.pn * 256 + bj * 128 + cgp;
                    const f32x4 v0 = acc[ai][bj][m][0] + *(const f32x4*)o, v1 = acc[ai][bj][m][1] + *(const f32x4*)(o + 4);
                    *(f32x4*)o = v0; *(f32x4*)(o + 4) = v1;
                }
            }
    }
};

__device__ __forceinline__ unsigned off_b(unsigned row, unsigned ch) { return 256u * row + 16u * (ch ^ (((row & 3u) << 2) | ((row >> 2) & 3u))); }
__device__ __forceinline__ unsigned row_addr16(unsigned lane, unsigned rb, unsigned s) { return off_b((lane & 15u) + 16u * rb, 4u * s + (lane >> 4)); }
__device__ __forceinline__ unsigned tr_addr16(unsigned lane, unsigned c, unsigned ks, unsigned t) {
    const unsigned g = lane >> 4, q = (lane & 15u) >> 2, p = lane & 3u;
    return off_b(32u * ks + 8u * g + 4u * t + q, 2u * c + (p >> 1)) + 8u * (p & 1u);
}
__device__ __forceinline__ void tr_frags4(unsigned img, unsigned lane, unsigned c, bf16x8 (&f)[4]) {
    const unsigned a0 = img + tr_addr16(lane, c, 0, 0), a1 = img + tr_addr16(lane, c, 0, 1);
    s16x4 r0, r1, r2, r3, r4, r5, r6, r7;
    asm volatile("ds_read_b64_tr_b16 %0, %8\n\t"
                 "ds_read_b64_tr_b16 %1, %9\n\t"
                 "ds_read_b64_tr_b16 %2, %8 offset:8192\n\t"
                 "ds_read_b64_tr_b16 %3, %9 offset:8192\n\t"
                 "ds_read_b64_tr_b16 %4, %8 offset:16384\n\t"
                 "ds_read_b64_tr_b16 %5, %9 offset:16384\n\t"
                 "ds_read_b64_tr_b16 %6, %8 offset:24576\n\t"
                 "ds_read_b64_tr_b16 %7, %9 offset:24576\n\t"
                 "s_waitcnt lgkmcnt(0)"
                 : "=&v"(r0), "=&v"(r1), "=&v"(r2), "=&v"(r3), "=&v"(r4), "=&v"(r5), "=&v"(r6), "=&v"(r7)
                 : "v"(a0), "v"(a1) : "memory");
    f[0] = (bf16x8){r0[0], r0[1], r0[2], r0[3], r1[0], r1[1], r1[2], r1[3]};
    f[1] = (bf16x8){r2[0], r2[1], r2[2], r2[3], r3[0], r3[1], r3[2], r3[3]};
    f[2] = (bf16x8){r4[0], r4[1], r4[2], r4[3], r5[0], r5[1], r5[2], r5[3]};
    f[3] = (bf16x8){r6[0], r6[1], r6[2], r6[3], r7[0], r7[1], r7[2], r7[3]};
}
#define MFMA16(a, b, c) __builtin_amdgcn_mfma_f32_16x16x32_bf16((a), (b), (c), 0, 0, 0)

template <bool SCALE>
__device__ __forceinline__ void stage_tile(LAS unsigned char* img, const bf16* src, size_t pitch, int tid, float zl) {
    v4u v[4];
#pragma unroll
    for (int k = 0; k < 4; ++k) { const int id = tid + 512 * k, row = id >> 4, ch = id & 15; v[k] = *(const v4u*)(src + (size_t)row * pitch + ch * 8); }
#pragma unroll
    for (int k = 0; k < 4; ++k) { const int id = tid + 512 * k, row = id >> 4, ch = id & 15;
        v4u w = v[k];
        if (SCALE) { f32x4 a, b; unpack8(w, a, b); const float z = __builtin_amdgcn_exp2f((float)(127 - row) * zl); w = pack8(a * z, b * z); }
        *(LAS v4u*)(img + off_b(row, ch)) = w; }
}

__device__ __forceinline__ void kv_unit(LAS unsigned char* lds, const bf16* proj, float* kv, int unit, int tid) {
    const int b = unit >> 6, h = (unit >> 4) & 3, c = unit & 15, row0 = b * SEQ + c * 128;
    const int lane = tid & 63, w = __builtin_amdgcn_readfirstlane(tid >> 6), fr = lane & 15, fq = lane >> 4;
    const float l2g = log2_gamma(h);
    LAS unsigned char* Kimg = lds; LAS unsigned char* Vimg = lds + 32768;
    stage_tile<true>(Kimg, proj + (size_t)row0 * PROJW + 512 + h * 128, PROJW, tid, l2g);
    stage_tile<false>(Vimg, proj + (size_t)row0 * PROJW + 1024 + h * 128, PROJW, tid, 0.f);
    __syncthreads();
    bf16x8 aK[4]; tr_frags4((unsigned)(size_t)Kimg, lane, w, aK);
    float* o = kv + (size_t)unit * 16384 + (size_t)(16 * w + 4 * fq) * 128 + fr;
#pragma unroll
    for (int nb = 0; nb < 8; ++nb) {
        bf16x8 bV[4]; tr_frags4((unsigned)(size_t)Vimg, lane, nb, bV);
        f32x4 acc = {0.f, 0.f, 0.f, 0.f};
#pragma unroll
        for (int s = 0; s < 4; ++s) acc = MFMA16(aK[s], bV[s], acc);
#pragma unroll
        for (int e = 0; e < 4; ++e) o[e * 128 + nb * 16] = acc[e];
    }
    __syncthreads();
}

__device__ __forceinline__ void sample_unit(LAS unsigned char* lds, const bf16* proj, const float* state_ret, const float* gn_g, bf16* mix, float* new_ret, int unit, int tid) {
    const int b = unit >> 2, h = unit & 3, row0 = NPROMPT + b * 8;
    const int lane = tid & 63, w = __builtin_amdgcn_readfirstlane(tid >> 6);
    LAS float* qT = (LAS float*)lds;
    LAS float* kzT = qT + 1024;
    LAS float* kT = kzT + 1024;
    LAS float* vs = kT + 1024;
    LAS float* sc = vs + 1024;
    LAS float* po = sc + 64;
    const float l2g = log2_gamma(h);
#pragma unroll
    for (int k2 = 0; k2 < 2; ++k2) {
        const int e = tid + 512 * k2, i = e >> 7, d = e & 127;
        const bf16* base = proj + (size_t)(row0 + i) * PROJW + h * 128 + d;
        const float q = bf2f(base[0]), k = bf2f(base[512]), v = bf2f(base[1024]);
        qT[d * 8 + i] = q; kT[d * 8 + i] = k; kzT[d * 8 + i] = k * __builtin_amdgcn_exp2f((float)(7 - i) * l2g); vs[i * 128 + d] = v;
    }
    __syncthreads();
    if (tid < 64) {
        const int i = tid >> 3, j = tid & 7; float s = 0.f;
        for (int d = 0; d < 128; ++d) s += qT[d * 8 + i] * kT[d * 8 + j];
        sc[i * 8 + j] = (j <= i) ? s * __builtin_amdgcn_exp2f((float)(i - j) * l2g) : 0.f;
    }
    const int v4 = (tid & 31) * 4, dg = tid >> 5;
    f32x4 vv[8], pacc[8];
#pragma unroll
    for (int j = 0; j < 8; ++j) { vv[j] = *(const LAS f32x4*)(vs + j * 128 + v4); pacc[j] = (f32x4){0.f, 0.f, 0.f, 0.f}; }
    const float g8 = __builtin_amdgcn_exp2f(8.0f * l2g);
    const float* Rin = state_ret + (size_t)(b * 4 + h) * 16384 + v4;
    float* Rout = new_ret + (size_t)(b * 4 + h) * 16384 + v4;
    f32x4 rr[8];
#pragma unroll
    for (int dd = 0; dd < 8; ++dd) rr[dd] = *(const f32x4*)(Rin + (size_t)(dg * 8 + dd) * 128);
#pragma unroll
    for (int dd = 0; dd < 8; ++dd) {
        const int d = dg * 8 + dd; const f32x4 r = rr[dd];
        const f32x4 q0 = *(const LAS f32x4*)(qT + d * 8), q1 = *(const LAS f32x4*)(qT + d * 8 + 4);
        const f32x4 z0 = *(const LAS f32x4*)(kzT + d * 8), z1 = *(const LAS f32x4*)(kzT + d * 8 + 4);
        f32x4 rn = r * g8;
#pragma unroll
        for (int i = 0; i < 4; ++i) { pacc[i] += r * q0[i]; pacc[4 + i] += r * q1[i]; rn += vv[i] * z0[i]; rn += vv[4 + i] * z1[i]; }
        *(f32x4*)(Rout + (size_t)d * 128) = rn;
    }
#pragma unroll
    for (int i = 0; i < 8; ++i) {
#pragma unroll
        for (int k = 0; k < 4; ++k) pacc[i][k] += __shfl_xor(pacc[i][k], 32);
        if (lane < 32) *(LAS f32x4*)(po + (w * 8 + i) * 128 + v4) = pacc[i];
    }
    __syncthreads();
    {
        const int i = w, v = lane * 2;
        float o0 = 0.f, o1 = 0.f;
#pragma unroll
        for (int ww = 0; ww < 8; ++ww) { o0 += po[(ww * 8 + i) * 128 + v]; o1 += po[(ww * 8 + i) * 128 + v + 1]; }
        const float xi = __builtin_amdgcn_exp2f((float)(i + 1) * l2g);
        o0 *= xi; o1 *= xi;
#pragma unroll
        for (int j = 0; j < 8; ++j) { const float s = sc[i * 8 + j]; o0 += s * vs[j * 128 + v]; o1 += s * vs[j * 128 + v + 1]; }
        const float mean = wave_sum(o0 + o1) * (1.0f / 128.0f);
        const float d0 = o0 - mean, d1 = o1 - mean;
        const float var = wave_sum(d0 * d0 + d1 * d1) * (1.0f / 128.0f);
        const float rstd = rsqrtf(var + 1e-5f);
        const unsigned gw = *(const unsigned*)(proj + (size_t)(row0 + i) * PROJW + 1536 + h * 128 + v);
        const float y0 = silu_f(bflo(gw)) * (d0 * rstd * gn_g[h * 128 + v]), y1 = silu_f(bfhi(gw)) * (d1 * rstd * gn_g[h * 128 + v + 1]);
        *(unsigned*)(mix + (size_t)(row0 + i) * DM + h * 128 + v) = cvt_pk_bf16(y0, y1);
    }
    __syncthreads();
}

__device__ __forceinline__ void conv_unit(const bf16* proj, const float* state_conv, const float* conv_w, bf16* mix, float* ncp, float* ncs, int unit, int tid) {
    const int cgp = (tid & 63) * 8, w = tid >> 6;
    const f32x4 w0a = *(const f32x4*)(conv_w + cgp), w0b = *(const f32x4*)(conv_w + cgp + 4);
    const f32x4 w1a = *(const f32x4*)(conv_w + 512 + cgp), w1b = *(const f32x4*)(conv_w + 512 + cgp + 4);
    const f32x4 w2a = *(const f32x4*)(conv_w + 1024 + cgp), w2b = *(const f32x4*)(conv_w + 1024 + cgp + 4);
#pragma unroll
    for (int rr = 0; rr < 4; ++rr) {
        const int m = unit * 32 + w + 8 * rr;
        const bool samp = m >= NPROMPT;
        const int l = samp ? (m & 7) : (m & (SEQ - 1)), bb = samp ? ((m - NPROMPT) >> 3) : (m >> 11);
        const bf16* pr = proj + (size_t)m * PROJW + cgp;
        f32x4 u2a, u2b, ga, gb, u1a, u1b, u0a, u0b;
        unpack8(*(const v4u*)(pr + 2560), u2a, u2b);
        unpack8(*(const v4u*)(pr + 2048), ga, gb);
        const f32x4 zero = {0.f, 0.f, 0.f, 0.f};
        if (l >= 1) unpack8(*(const v4u*)(pr + 2560 - PROJW), u1a, u1b);
        else if (samp) { const float* s = state_conv + (size_t)(bb * 2 + 1) * 512 + cgp; u1a = *(const f32x4*)s; u1b = *(const f32x4*)(s + 4); }
        else { u1a = zero; u1b = zero; }
        if (l >= 2) unpack8(*(const v4u*)(pr + 2560 - 2 * PROJW), u0a, u0b);
        else if (samp) { const float* s = state_conv + (size_t)(bb * 2 + l) * 512 + cgp; u0a = *(const f32x4*)s; u0b = *(const f32x4*)(s + 4); }
        else { u0a = zero; u0b = zero; }
        const f32x4 ya = w0a * u0a + w1a * u1a + w2a * u2a, yb = w0b * u0b + w1b * u1b + w2b * u2b;
        *(v4u*)(mix + (size_t)m * DM + 512 + cgp) = pack8(ga * ya, gb * yb);
        const int L = samp ? 8 : SEQ;
        if (l >= L - 2) { float* d = (samp ? ncs : ncp) + (size_t)(bb * 2 + (l - (L - 2))) * 512 + cgp; *(f32x4*)d = u2a; *(f32x4*)(d + 4) = u2b; }
    }
}

__device__ __forceinline__ void ro_unit(LAS unsigned char* lds, const bf16* proj, const bf16* rs, const float* gn_g, bf16* mix, int unit, int tid) {
    const int b = unit >> 6, h = (unit >> 4) & 3, c = unit & 15, row0 = b * SEQ + c * 128;
    const int lane = tid & 63, w = __builtin_amdgcn_readfirstlane(tid >> 6), fr = lane & 15, fq = lane >> 4;
    const float l2g = log2_gamma(h);
    LAS unsigned char* Qimg = lds; LAS unsigned char* Kimg = lds + 32768; LAS unsigned char* Vimg = lds + 65536; LAS unsigned char* Rimg = lds + 98304;
    const bf16* pb = proj + (size_t)row0 * PROJW + h * 128;
    stage_tile<false>(Qimg, pb, PROJW, tid, 0.f);
    stage_tile<false>(Kimg, pb + 512, PROJW, tid, 0.f);
    stage_tile<false>(Vimg, pb + 1024, PROJW, tid, 0.f);
    stage_tile<false>(Rimg, rs + (size_t)unit * 16384, 128, tid, 0.f);
    __syncthreads();
    bf16x8 aQ[4];
#pragma unroll
    for (int s = 0; s < 4; ++s) aQ[s] = *(const LAS bf16x8*)(Qimg + row_addr16(lane, w, s));
    f32x4 accI[8], accO[8];
#pragma unroll
    for (int nb = 0; nb < 8; ++nb) {
        bf16x8 bR[4]; tr_frags4((unsigned)(size_t)Rimg, lane, nb, bR);
        f32x4 a = {0.f, 0.f, 0.f, 0.f};
#pragma unroll
        for (int s = 0; s < 4; ++s) a = MFMA16(aQ[s], bR[s], a);
        accI[nb] = a;
    }
    const int il = 16 * w + fr;
#pragma unroll
    for (int jb = 0; jb < 8; ++jb) {
        v2u pw = {0u, 0u};
        if (jb <= w) {
            f32x4 a = {0.f, 0.f, 0.f, 0.f};
#pragma unroll
            for (int s = 0; s < 4; ++s) { const bf16x8 kf = *(const LAS bf16x8*)(Kimg + row_addr16(lane, jb, s)); a = MFMA16(kf, aQ[s], a); }
            float p[4];
#pragma unroll
            for (int e = 0; e < 4; ++e) { const int dlt = il - (16 * jb + 4 * fq + e); p[e] = dlt >= 0 ? a[e] * __builtin_amdgcn_exp2f((float)dlt * l2g) : 0.f; }
            pw.x = cvt_pk_bf16(p[0], p[1]); pw.y = cvt_pk_bf16(p[2], p[3]);
        }
        *(LAS v2u*)(Qimg + off_b(il, 2 * jb + (fq >> 1)) + 8 * (fq & 1)) = pw;
    }
    bf16x8 aP[4];
#pragma unroll
    for (int s = 0; s < 4; ++s) aP[s] = *(const LAS bf16x8*)(Qimg + row_addr16(lane, w, s));
#pragma unroll
    for (int nb = 0; nb < 8; ++nb) {
        bf16x8 bV[4]; tr_frags4((unsigned)(size_t)Vimg, lane, nb, bV);
        f32x4 a = {0.f, 0.f, 0.f, 0.f};
#pragma unroll
        for (int s = 0; s < 4; ++s) a = MFMA16(aP[s], bV[s], a);
        accO[nb] = a;
    }
    float gg[8];
#pragma unroll
    for (int nb = 0; nb < 8; ++nb) gg[nb] = gn_g[h * 128 + nb * 16 + fr];
#pragma unroll
    for (int e = 0; e < 4; ++e) {
        const float xi = __builtin_amdgcn_exp2f((float)(16 * w + 4 * fq + e + 1) * l2g);
        float o[8], s = 0.f;
#pragma unroll
        for (int nb = 0; nb < 8; ++nb) { o[nb] = accO[nb][e] + xi * accI[nb][e]; s += o[nb]; }
        s += __shfl_xor(s, 1); s += __shfl_xor(s, 2); s += __shfl_xor(s, 4); s += __shfl_xor(s, 8);
        const float mean = s * (1.0f / 128.0f); float q = 0.f;
#pragma unroll
        for (int nb = 0; nb < 8; ++nb) { o[nb] -= mean; q += o[nb] * o[nb]; }
        q += __shfl_xor(q, 1); q += __shfl_xor(q, 2); q += __shfl_xor(q, 4); q += __shfl_xor(q, 8);
        const float rstd = rsqrtf(q * (1.0f / 128.0f) + 1e-5f);
        const unsigned ro = 16 * w + 4 * fq + e;
#pragma unroll
        for (int nb = 0; nb < 8; ++nb)
            *(LAS unsigned short*)(Qimg + off_b(ro, 2 * nb + (fr >> 3)) + 2 * (fr & 7)) = (unsigned short)(cvt_pk_bf16(o[nb] * rstd * gg[nb], 0.f) & 0xffffu);
    }
#pragma unroll
    for (int k = 0; k < 4; ++k) {
        const int id = lane + 64 * k, r = id >> 4, ch = id & 15;
        const v4u ov = *(const LAS v4u*)(Qimg + off_b(16 * w + r, ch));
        const size_t grow = (size_t)(row0 + 16 * w + r);
        const v4u gv = *(const v4u*)(proj + grow * PROJW + 1536 + h * 128 + ch * 8);
        f32x4 oa, ob, ga, gb; unpack8(ov, oa, ob); unpack8(gv, ga, gb);
        const f32x4 ya = {silu_f(ga[0]) * oa[0], silu_f(ga[1]) * oa[1], silu_f(ga[2]) * oa[2], silu_f(ga[3]) * oa[3]};
        const f32x4 yb = {silu_f(gb[0]) * ob[0], silu_f(gb[1]) * ob[1], silu_f(gb[2]) * ob[2], silu_f(gb[3]) * ob[3]};
        *(v4u*)(mix + grow * DM + h * 128 + ch * 8) = pack8(ya, yb);
    }
    __syncthreads();
}

__device__ __forceinline__ void p0_transpose_item(const float* W, int K, int N, bf16* WT, int k0, int n0, int dst_row0, LAS float* scr, int lane) {
#pragma unroll 8
    for (int i = 0; i < 32; ++i) { const int kk = 2 * i + (lane >> 5); scr[kk * 33 + (lane & 31)] = W[(size_t)(k0 + kk) * N + n0 + (lane & 31)]; }
    LDS_WAIT(); asm volatile("" ::: "memory");
    const int c = lane & 7;
#pragma unroll
    for (int j = 0; j < 4; ++j) { const int n = (lane >> 3) + 8 * j; const LAS float* s = scr + (8 * c) * 33 + n;
        v4u o; o.x = cvt_pk_bf16(s[0 * 33], s[1 * 33]); o.y = cvt_pk_bf16(s[2 * 33], s[3 * 33]); o.z = cvt_pk_bf16(s[4 * 33], s[5 * 33]); o.w = cvt_pk_bf16(s[6 * 33], s[7 * 33]);
        *(v4u*)(WT + (size_t)(dst_row0 + n) * K + k0 + 8 * c) = o; }
    LDS_WAIT(); asm volatile("" ::: "memory");
}
__device__ __forceinline__ int win_dst(int s) {
    if (s < 1024) { const int sec = s >> 9, hh = (s & 511) >> 7, dpos = s & 127; return (sec * 2 + (hh >> 1)) * 256 + (dpos >> 6) * 128 + (hh & 1) * 64 + (dpos & 63); }
    if (s < 2560) return s;
    if (s < 3072) { const int i = s - 2560; return (10 + (i >> 7)) * 256 + (i & 127); }
    const int i = s - 3072; return (10 + (i >> 7)) * 256 + 128 + (i & 127);
}

struct Args { const float* in[14]; float* out; unsigned char* ws; int lo, hi; };

__global__ void __launch_bounds__(NWAVES * 64, 2) mk_fwd(Args a) {
    extern __shared__ __attribute__((aligned(16))) unsigned char lds_raw[];
    LAS unsigned char* lds = (LAS unsigned char*)lds_raw;
    const int tid = threadIdx.x, lane = tid & 63, wave = __builtin_amdgcn_readfirstlane(tid >> 6);
    const int G = gridDim.x, bx = blockIdx.x;
    const int lo = a.lo, hi = a.hi;
    const float *x_prompt = a.in[0], *x_sample = a.in[1], *state_conv = a.in[2], *state_ret = a.in[3], *norm1_g = a.in[4], *w_in = a.in[5], *conv_w = a.in[6],
                *ret_gn_g = a.in[7], *w_out = a.in[8], *norm2_g = a.in[9], *w_gate = a.in[10], *w_up = a.in[11], *w_down = a.in[12], *norm_f_g = a.in[13];
    unsigned char* ws = a.ws; float* out = a.out;
    bf16* Wt_in = (bf16*)(ws + WS_WIN); bf16* Wt_out = (bf16*)(ws + WS_WOUT); bf16* Wt_gu = (bf16*)(ws + WS_WGU); bf16* Wt_dn = (bf16*)(ws + WS_WDN);
    float* CS = (float*)(ws + WS_CS); float* SS2 = (float*)(ws + WS_SS2);
    bf16* XN = (bf16*)(ws + WS_XN); bf16* PROJ = (bf16*)(ws + WS_PROJ); bf16* ACT = (bf16*)(ws + WS_PROJ);
    float* KV = (float*)(ws + WS_KV); bf16* RS = (bf16*)(ws + WS_RS); bf16* MIX = (bf16*)(ws + WS_MIX);
#define IN(k) (lo <= (k) && (k) < hi)
#define SEAM(k) do { if (IN(k) && IN((k) + 1)) { cg::this_grid().sync(); } } while (0)

    if (IN(0)) {
        LAS float* scr = (LAS float*)(lds + wave * 16384);
        const int gw = bx * NWAVES + wave, NGW = G * NWAVES;
        constexpr int I_IN = 16 * (NIN / 32), I_OUT = 16 * 32, I_G = 16 * (FF / 32), I_DN = (FF / 64) * 32;
        constexpr int NITEMS = I_IN + I_OUT + 2 * I_G + I_DN;
        for (int it = gw; it < NITEMS; it += NGW) {
            int r = it;
            if (r < I_IN) { const int kb = r / (NIN / 32), nb = r % (NIN / 32); p0_transpose_item(w_in, DM, NIN, Wt_in, 64 * kb, 32 * nb, win_dst(32 * nb), scr, lane); continue; } r -= I_IN;
            if (r < I_OUT) { const int kb = r / 32, nb = r % 32; p0_transpose_item(w_out, DM, DM, Wt_out, 64 * kb, 32 * nb, 32 * nb, scr, lane); continue; } r -= I_OUT;
            if (r < I_G) { const int kb = r / (FF / 32), nb = r % (FF / 32), s = 32 * nb; p0_transpose_item(w_gate, DM, FF, Wt_gu, 64 * kb, s, (s >> 7) * 256 + (s & 127), scr, lane); continue; } r -= I_G;
            if (r < I_G) { const int kb = r / (FF / 32), nb = r % (FF / 32), s = 32 * nb; p0_transpose_item(w_up, DM, FF, Wt_gu, 64 * kb, s, (s >> 7) * 256 + 128 + (s & 127), scr, lane); continue; } r -= I_G;
            { const int kb = r / 32, nb = r % 32; p0_transpose_item(w_down, FF, DM, Wt_dn, 64 * kb, 32 * nb, 32 * nb, scr, lane); }
        }
        for (int m = gw; m < M; m += NGW) {
            const float* xrow = m < NPROMPT ? x_prompt + (size_t)m * DM : x_sample + (size_t)(m - NPROMPT) * DM;
            const f32x4* xr = (const f32x4*)xrow + lane; f32x4 v[4]; float s = 0.f;
#pragma unroll
            for (int j = 0; j < 4; ++j) { v[j] = xr[64 * j]; s += (v[j][0] * v[j][0] + v[j][1] * v[j][1]) + (v[j][2] * v[j][2] + v[j][3] * v[j][3]); }
            const float r = rsqrtf(wave_sum(s) * (1.0f / DM) + 1e-6f);
            v2u* o8 = (v2u*)(XN + (size_t)m * DM) + lane;
#pragma unroll
            for (int j = 0; j < 4; ++j) { const f32x4 g = ((const f32x4*)norm1_g)[lane + 64 * j]; const f32x4 y = v[j] * r * g; v2u wv; wv.x = cvt_pk_bf16(y[0], y[1]); wv.y = cvt_pk_bf16(y[2], y[3]); o8[64 * j] = wv; }
        }
        for (int e = bx * 512 + tid; e < (SEQ + 8) * 64; e += G * 512) {
            const int p = e >> 6, i = e & 63;
            const double pos = p < SEQ ? (double)p : (double)(16384 + (p - SEQ));
            const double inv = exp2(-(double)i * (13.287712379549449 / 64.0));
            const double rev = pos * inv * 0.15915494309189535;
            const float fr_ = (float)(rev - floor(rev));
            CS[(size_t)p * 128 + i] = __builtin_amdgcn_cosf(fr_); CS[(size_t)p * 128 + 64 + i] = __builtin_amdgcn_sinf(fr_);
        }
    }
    SEAM(0);
    if (IN(1)) {
        pg8::Gemm g{XN, Wt_in, M, NIN, DM}; pg8::StaticOrder S; S.init(M, NIN, G, bx);
        EpiInProj E{PROJ, CS};
        pg8::gemm_phase<EpiInProj, pg8::StaticOrder, true, true>(lds, g, S, E);
    }
    SEAM(1);
    if (IN(2)) {
        for (int it = bx; it < 512; it += G) kv_unit(lds, PROJ, KV, it, tid);
        for (int it = bx; it < 512; it += G) sample_unit(lds, PROJ, state_ret, ret_gn_g, MIX, out + OUT_NRS, it, tid);
        for (int it = bx; it < M / 32; it += G) conv_unit(PROJ, state_conv, conv_w, MIX, out + OUT_NCP, out + OUT_NCS, it, tid);
    }
    SEAM(2);
    if (IN(3)) {
        for (int e = bx * 512 + tid; e < 32 * 16384; e += G * 512) {
            const int bh = e >> 14, dv = e & 16383, h = bh & 3;
            const float g128 = __builtin_amdgcn_exp2f(128.0f * log2_gamma(h));
            const float* kvp = KV + (size_t)bh * 16 * 16384 + dv; bf16* rp = RS + (size_t)bh * 16 * 16384 + dv;
            float kvv[16];
#pragma unroll
            for (int c = 0; c < 16; ++c) kvv[c] = kvp[(size_t)c * 16384];
            float r = 0.f;
#pragma unroll
            for (int c = 0; c < 16; ++c) { rp[(size_t)c * 16384] = (bf16)(cvt_pk_bf16(r, 0.f) & 0xffffu); r = r * g128 + kvv[c]; }
            out[OUT_NRP + e] = r;
        }
    }
    SEAM(3);
    if (IN(4)) {
        for (int it = bx; it < 512; it += G) ro_unit(lds, PROJ, RS, ret_gn_g, MIX, it, tid);
    }
    SEAM(4);
    if (IN(5)) {
        pg8::Gemm g{MIX, Wt_out, M, DM, DM}; pg8::StaticOrder S; S.init(M, DM, G, bx);
        EpiOut E{x_prompt, x_sample, out + OUT_Y, XN, norm2_g, SS2};
        pg8::gemm_phase<EpiOut, pg8::StaticOrder, true, true>(lds, g, S, E);
    }
    SEAM(5);
    if (IN(6)) {
        pg8::Gemm g{XN, Wt_gu, M, NGU, DM}; pg8::StaticOrder S; S.init(M, NGU, G, bx);
        EpiGU E{SS2, ACT};
        pg8::gemm_phase<EpiGU, pg8::StaticOrder, true, true>(lds, g, S, E);
    }
    SEAM(6);
    if (IN(7)) {
        pg8::Gemm g{ACT, Wt_dn, M, DM, FF}; pg8::StaticOrder S; S.init(M, DM, G, bx);
        EpiDown E{out + OUT_Y};
        pg8::gemm_phase<EpiDown, pg8::StaticOrder, true, true>(lds, g, S, E);
    }
    SEAM(7);
    if (IN(8)) {
        const int gw = bx * NWAVES + wave, NGW = G * NWAVES;
        for (int m = gw; m < M; m += NGW) {
            f32x4* xr = (f32x4*)(out + OUT_Y + (size_t)m * DM) + lane; f32x4 v[4]; float s = 0.f;
#pragma unroll
            for (int j = 0; j < 4; ++j) { v[j] = xr[64 * j]; s += (v[j][0] * v[j][0] + v[j][1] * v[j][1]) + (v[j][2] * v[j][2] + v[j][3] * v[j][3]); }
            const float r = rsqrtf(wave_sum(s) * (1.0f / DM) + 1e-6f);
#pragma unroll
            for (int j = 0; j < 4; ++j) { const f32x4 g = ((const f32x4*)norm_f_g)[lane + 64 * j]; xr[64 * j] = v[j] * r * g; }
        }
    }
#undef IN
#undef SEAM
}

extern "C" void kernel_launch(void* const* d_in, const int* in_sizes, int n_in, void* d_out, int out_size, void* d_ws, size_t ws_size, hipStream_t stream) {
    static int grid = 0;
    if (grid == 0) {
        if (n_in != 14 || ws_size < WS_END) { fprintf(stderr, "kernel_launch: unexpected n_in %d / ws_size %zu\n", n_in, ws_size); grid = -1; return; }
        int dev = 0, cus = 0, per_cu = 0;
        if (hipGetDevice(&dev) != hipSuccess || hipDeviceGetAttribute(&cus, hipDeviceAttributeMultiprocessorCount, dev) != hipSuccess) { grid = -1; return; }
        if (hipFuncSetAttribute((const void*)mk_fwd, hipFuncAttributeMaxDynamicSharedMemorySize, LDS_BYTES) != hipSuccess) { fprintf(stderr, "kernel_launch: hipFuncSetAttribute failed\n"); grid = -1; return; }
        if (hipOccupancyMaxActiveBlocksPerMultiprocessor(&per_cu, (const void*)mk_fwd, NWAVES * 64, LDS_BYTES) != hipSuccess || per_cu < 1) { fprintf(stderr, "kernel_launch: occupancy query gave %d\n", per_cu); (void)hipGetLastError(); per_cu = 1; }
        grid = cus * per_cu;
    }
    if (grid < 0) return;
    Args a{};
    for (int i = 0; i < 14; ++i) a.in[i] = (const float*)d_in[i];
    a.out = (float*)d_out; a.ws = (unsigned char*)d_ws;
#if MK_N_LAUNCHES == 1
    a.lo = 0; a.hi = NPHASE;
    void* args[] = {&a};
    hipError_t e = hipLaunchCooperativeKernel((const void*)mk_fwd, dim3(grid), dim3(NWAVES * 64), args, LDS_BYTES, stream);
    if (e != hipSuccess) fprintf(stderr, "kernel_launch: cooperative launch failed: %s (grid %d)\n", hipGetErrorString(e), grid);
#else
    for (int p = 0; p < NPHASE; ++p) {
        a.lo = p; a.hi = p + 1;
        hipLaunchKernelGGL(mk_fwd, dim3(grid), dim3(NWAVES * 64), LDS_BYTES, stream, a);
    }
#endif
}
```

```cpp
#include <hip/hip_runtime.h>
#include <hip/hip_cooperative_groups.h>
#include <cstdio>
#include <cstdint>
namespace cg = cooperative_groups;
#define MK_N_LAUNCHES 1
namespace pg8 {
#define PG8_LAS __attribute__((address_space(3)))
typedef unsigned short bf16_t;
typedef short bf16x8 __attribute__((ext_vector_type(8)));
typedef float f32x4 __attribute__((ext_vector_type(4)));
typedef unsigned u32x4 __attribute__((ext_vector_type(4)));
constexpr int BM = 256, BK = 64, HALF = 128, HTB = HALF * BK * 2  , STAGE_BYTES = 8 * HTB, NXCD = 8, WGM = 8;

__host__ __device__ __forceinline__ int lds_byte(int r, int c) { const int st = (r >> 4) * 2 + (c >> 5), rr = r & 15, cc = c & 31, ob = rr * 64 + cc * 2; return st * 1024 + (ob ^ (((ob >> 9) & 1) << 5)); }
__host__ __device__ __forceinline__ void stage_rc(int b, int& R, int& C) { const int st = b / 1024, sb = b % 1024, swz = sb ^ (((sb >> 9) & 1) << 5); R = (st >> 1) * 16 + swz / 64; C = (st & 1) * 32 + (swz % 64) / 2; }
__host__ __device__ __forceinline__ int perm32(int rho) { const int n = rho >> 4, i = rho & 15; return 8 * (i >> 2) + 4 * n + (i & 3); }

struct Unit { int pm, pn; };
struct Gemm { const bf16_t* A; const bf16_t* Bt; int M, N, K; };

struct StaticOrder {
    int nM, nN, nwg, G, c;
    __host__ __device__ void init(int M, int N, int G_, int c_) { nM = M / BM; nN = N / BM; nwg = nM * nN; G = G_; c = c_; }
    __host__ __device__ bool next(int i, Unit& u) const {
        const long L = (long)i * G + c; if (L >= nwg) return false;
        int wgid = (int)L; { const int q = nwg / NXCD, r = nwg % NXCD, xcd = wgid % NXCD, off = wgid / NXCD; wgid = (xcd < r ? xcd * (q + 1) : r * (q + 1) + (xcd - r) * q) + off; }
        const int nig = WGM * nN, gid = wgid / nig, fm = gid * WGM, gsz = (nM - fm) < WGM ? (nM - fm) : WGM;
        u.pm = fm + ((wgid % nig) % gsz); u.pn = (wgid % nig) / gsz; return true;
    }
    __device__ __forceinline__ void a_ready(const Unit&) const {}
    __device__ __forceinline__ void done(const Unit&) const {}
};

__device__ __forceinline__ unsigned cvt_pk_bf16(float lo, float hi) { unsigned r; asm volatile("v_cvt_pk_bf16_f32 %0, %1, %2" : "=v"(r) : "v"(lo), "v"(hi)); return r; }
template <class Epi, class Sched, bool ALIGN_EPI = false, bool SP2 = false>
__device__ __forceinline__ void gemm_phase(PG8_LAS unsigned char* lds, const Gemm g, const Sched& S, const Epi& E) {
    const int tid = threadIdx.x, wid = __builtin_amdgcn_readfirstlane(tid >> 6), lane = tid & 63, wr = wid >> 2, wc = wid & 3, fr = lane & 15, fq = lane >> 4;
    const int K = g.K, nt = K / BK;
    unsigned voffA[2], voffB[2];
#pragma unroll
    for (int i = 0; i < 2; ++i) { int R, C; stage_rc(tid * 16 + i * 8192, R, C); const int Rb = Epi::PERM ? ((R & ~31) + perm32(R & 31)) : R;
        voffA[i] = (unsigned)(R * K + C) * 2u; voffB[i] = (unsigned)(Rb * K + C) * 2u; }
    const size_t kstep = (size_t)(BK * 2);
    const size_t hstep = (size_t)HALF * K * 2;
    const size_t tstep = 2 * hstep;
    const unsigned ldsw = (unsigned)wid * 1024u;
    const int aoff = lds_byte(wr * 64 + fr, fq * 8), boff = lds_byte(wc * 32 + fr, fq * 8);
#define PG8_SA(b, h) (((b) * 2 + (h)) * HTB)
#define PG8_SB(b, h) ((4 + (b) * 2 + (h)) * HTB)
#define PG8_STAGE(bufoff, gbase, voff) do { _Pragma("unroll") for (int _i = 0; _i < 2; ++_i) \
        __builtin_amdgcn_global_load_lds((const unsigned*)((const char*)(gbase) + (voff)[_i]), (PG8_LAS unsigned*)(lds + (bufoff) + ldsw + _i * 8192), 16, 0, 0); } while (0)
#define PG8_LDA(dst, b, h) do { _Pragma("unroll") for (int m = 0; m < 4; ++m) _Pragma("unroll") for (int k = 0; k < 2; ++k) dst[m][k] = *(const PG8_LAS bf16x8*)(lds + PG8_SA(b, h) + aoff + m * 2048 + k * 1024); } while (0)
#define PG8_LDB(dst, b, h) do { _Pragma("unroll") for (int n = 0; n < 2; ++n) _Pragma("unroll") for (int k = 0; k < 2; ++k) dst[n][k] = *(const PG8_LAS bf16x8*)(lds + PG8_SB(b, h) + boff + n * 2048 + k * 1024); } while (0)
#define PG8_MMA(ai, bj, At, Bt) do { __builtin_amdgcn_s_setprio(1); _Pragma("unroll") for (int m = 0; m < 4; ++m) _Pragma("unroll") for (int n = 0; n < 2; ++n) _Pragma("unroll") for (int k = 0; k < 2; ++k) \
        acc[ai][bj][m][n] = __builtin_amdgcn_mfma_f32_16x16x32_bf16(Bt[n][k], At[m][k], acc[ai][bj][m][n], 0, 0, 0); __builtin_amdgcn_s_setprio(0); } while (0)
#define PG8_WAIT_V(n) asm volatile("s_waitcnt vmcnt(" #n ")" ::: "memory")
#define PG8_WAIT_L(n) asm volatile("s_waitcnt lgkmcnt(" #n ")" ::: "memory")
#define PG8_BAR __builtin_amdgcn_s_barrier()
#define PG8_SCHED __builtin_amdgcn_sched_barrier(0)
    Unit cur, nxt; int ui = 0;
    if (!S.next(0, cur)) return;
    f32x4 acc[2][2][4][2];
#pragma unroll
    for (int a = 0; a < 2; ++a)
#pragma unroll
        for (int b = 0; b < 2; ++b)
#pragma unroll
            for (int m = 0; m < 4; ++m)
#pragma unroll
                for (int n = 0; n < 2; ++n) acc[a][b][m][n] = (f32x4){0.f, 0.f, 0.f, 0.f};
    bf16x8 At[4][2], B0[2][2], B1[2][2];
    const char* cA = (const char*)g.A + (size_t)cur.pm * tstep; const char* cB = (const char*)g.Bt + (size_t)cur.pn * tstep;
    S.a_ready(cur);
    if constexpr (SP2) {
        PG8_STAGE(PG8_SB(0, 0), cB, voffB); PG8_STAGE(PG8_SB(0, 1), cB + hstep, voffB); PG8_STAGE(PG8_SA(0, 0), cA, voffA); PG8_STAGE(PG8_SA(0, 1), cA + hstep, voffA);
        if (wr == 1) PG8_BAR;
        PG8_WAIT_V(2); PG8_BAR;
        PG8_STAGE(PG8_SB(1, 0), cB + kstep, voffB); PG8_STAGE(PG8_SA(1, 0), cA + kstep, voffA); PG8_STAGE(PG8_SB(1, 1), cB + hstep + kstep, voffB);
        PG8_WAIT_V(6); PG8_BAR;
    } else {
        PG8_STAGE(PG8_SB(0, 0), cB, voffB); PG8_STAGE(PG8_SA(0, 0), cA, voffA); PG8_STAGE(PG8_SB(0, 1), cB + hstep, voffB); PG8_STAGE(PG8_SA(0, 1), cA + hstep, voffA);
        if (wr == 1) PG8_BAR;
        PG8_WAIT_V(4); PG8_BAR;
        PG8_STAGE(PG8_SB(1, 0), cB + kstep, voffB); PG8_STAGE(PG8_SA(1, 0), cA + kstep, voffA); PG8_STAGE(PG8_SB(1, 1), cB + hstep + kstep, voffB);
        PG8_WAIT_V(6); PG8_BAR;
    }
    for (;;) {
        const bool has_next = S.next(ui + 1, nxt);
        const char* nA = has_next ? (const char*)g.A + (size_t)nxt.pm * tstep : cA; const char* nB = has_next ? (const char*)g.Bt + (size_t)nxt.pn * tstep : cB;
        for (int t = 0; t < nt; t += 2) {
            const bool last = (t == nt - 2);
            const char* a1 = cA + (size_t)(t + 1) * kstep;
            const char* a2 = last ? nA : cA + (size_t)(t + 2) * kstep; const char* b2 = last ? nB : cB + (size_t)(t + 2) * kstep;
            const char* a3 = a2 + kstep; const char* b3 = b2 + kstep;
            if (last && has_next) S.a_ready(nxt);
            if constexpr (SP2) {
            PG8_LDB(B0, 0, 0); PG8_LDB(B1, 0, 1); PG8_SCHED; PG8_LDA(At, 0, 0); PG8_STAGE(PG8_SA(1, 1), a1 + hstep, voffA);
            PG8_WAIT_V(8); PG8_WAIT_L(0); PG8_BAR; PG8_MMA(0, 0, At, B0); PG8_MMA(0, 1, At, B1); PG8_BAR; PG8_SCHED;
            PG8_LDA(At, 0, 1); PG8_STAGE(PG8_SB(0, 0), b2, voffB); PG8_STAGE(PG8_SB(0, 1), b2 + hstep, voffB); PG8_STAGE(PG8_SA(0, 0), a2, voffA);
            PG8_WAIT_V(8); PG8_WAIT_L(0); PG8_BAR; PG8_MMA(1, 0, At, B0); PG8_MMA(1, 1, At, B1); PG8_BAR; PG8_SCHED;
            PG8_LDB(B0, 1, 0); PG8_LDB(B1, 1, 1); PG8_SCHED; PG8_LDA(At, 1, 0); PG8_STAGE(PG8_SA(0, 1), a2 + hstep, voffA);
            PG8_WAIT_V(8); PG8_WAIT_L(0); PG8_BAR; PG8_MMA(0, 0, At, B0); PG8_MMA(0, 1, At, B1); PG8_BAR; PG8_SCHED;
            PG8_LDA(At, 1, 1); PG8_STAGE(PG8_SB(1, 0), b3, voffB); PG8_STAGE(PG8_SB(1, 1), b3 + hstep, voffB); PG8_STAGE(PG8_SA(1, 0), a3, voffA);
            PG8_WAIT_V(8); PG8_WAIT_L(0); PG8_BAR; PG8_MMA(1, 0, At, B0); PG8_MMA(1, 1, At, B1); PG8_BAR; PG8_SCHED;
            } else {
            PG8_LDB(B0, 0, 0); PG8_SCHED; PG8_LDA(At, 0, 0); PG8_STAGE(PG8_SA(1, 1), a1 + hstep, voffA);
            PG8_WAIT_L(8); PG8_BAR; PG8_WAIT_L(0); PG8_MMA(0, 0, At, B0); PG8_BAR; PG8_SCHED;
            PG8_LDB(B1, 0, 1); PG8_STAGE(PG8_SB(0, 0), b2, voffB);
            PG8_BAR; PG8_WAIT_L(0); PG8_MMA(0, 1, At, B1); PG8_BAR;
            PG8_LDA(At, 0, 1); PG8_STAGE(PG8_SA(0, 0), a2, voffA);
            PG8_BAR; PG8_WAIT_L(0); PG8_MMA(1, 0, At, B0); PG8_BAR; PG8_SCHED;
            PG8_STAGE(PG8_SB(0, 1), b2 + hstep, voffB);
            PG8_WAIT_V(6); PG8_BAR; PG8_MMA(1, 1, At, B1); PG8_BAR;
            PG8_LDB(B0, 1, 0); PG8_SCHED; PG8_LDA(At, 1, 0); PG8_STAGE(PG8_SA(0, 1), a2 + hstep, voffA);
            PG8_WAIT_L(8); PG8_BAR; PG8_WAIT_L(0); PG8_MMA(0, 0, At, B0); PG8_BAR; PG8_SCHED;
            PG8_LDB(B1, 1, 1); PG8_STAGE(PG8_SB(1, 0), b3, voffB);
            PG8_BAR; PG8_WAIT_L(0); PG8_MMA(0, 1, At, B1); PG8_BAR;
            PG8_LDA(At, 1, 1); PG8_STAGE(PG8_SA(1, 0), a3, voffA);
            PG8_BAR; PG8_WAIT_L(0); PG8_MMA(1, 0, At, B0); PG8_BAR; PG8_SCHED;
            PG8_STAGE(PG8_SB(1, 1), b3 + hstep, voffB);
            PG8_WAIT_V(6); PG8_BAR; PG8_MMA(1, 1, At, B1); PG8_BAR;
            }
        }
        if constexpr (ALIGN_EPI) { if (wr == 0) PG8_BAR; }
        if constexpr (!Epi::AFTER_DRAIN) { E(acc, cur, wr, wc, fr, fq); S.done(cur); }
        if (!has_next) break;
#pragma unroll
        for (int a = 0; a < 2; ++a)
#pragma unroll
            for (int b = 0; b < 2; ++b)
#pragma unroll
                for (int m = 0; m < 4; ++m)
#pragma unroll
                    for (int n = 0; n < 2; ++n) acc[a][b][m][n] = (f32x4){0.f, 0.f, 0.f, 0.f};
        cur = nxt; cA = nA; cB = nB; ++ui;
        if constexpr (ALIGN_EPI) { if (wr == 1) PG8_BAR; }
    }
    PG8_WAIT_V(0);
    if constexpr (!ALIGN_EPI) { if (wr == 0) PG8_BAR; }
    PG8_BAR;
    if constexpr (Epi::AFTER_DRAIN) { E.fused(acc, cur, wr, wc, fr, fq, lds, wid, lane); S.done(cur); }
#undef PG8_SA
#undef PG8_SB
#undef PG8_STAGE
#undef PG8_LDA
#undef PG8_LDB
#undef PG8_MMA
#undef PG8_WAIT_V
#undef PG8_WAIT_L
#undef PG8_BAR
#undef PG8_SCHED
}
}

#ifndef MK_N_LAUNCHES
#define MK_N_LAUNCHES 1
#endif
constexpr int DM = 1024, NPROMPT = 16384, M = 17408, SEQ = 2048;
constexpr int NIN = 3584, PROJW = 3072, FF = 2816, NGU = 5632;
constexpr int NPHASE = 9;
constexpr int NWAVES = 8;
constexpr size_t MiB = 1u << 20;
constexpr size_t WS_WIN = 0, WS_WOUT = 7 * MiB, WS_WGU = 9 * MiB, WS_WDN = 20 * MiB, WS_CS = 26 * MiB, WS_SS2 = 28 * MiB;
constexpr size_t WS_XN = 30 * MiB;
constexpr size_t WS_PROJ = 64 * MiB;
constexpr size_t WS_KV = 166 * MiB;
constexpr size_t WS_RS = 198 * MiB;
constexpr size_t WS_MIX = 214 * MiB;
constexpr size_t WS_END = 248 * MiB;
constexpr int LDS_BYTES = 147456, MISC_OFF = 143360;
constexpr size_t WS_CTL = 29 * MiB + 512 * 1024, CTL_BYTES = 16384;
constexpr size_t OUT_Y = 0, OUT_NCP = (size_t)M * DM, OUT_NRP = OUT_NCP + 8192, OUT_NCS = OUT_NRP + 524288, OUT_NRS = OUT_NCS + 131072;

#define GAS __attribute__((address_space(1)))
#define LAS __attribute__((address_space(3)))
typedef unsigned short bf16;
typedef unsigned v4u __attribute__((ext_vector_type(4)));
typedef unsigned v2u __attribute__((ext_vector_type(2)));
typedef float f32x4 __attribute__((ext_vector_type(4)));
typedef short bf16x8 __attribute__((ext_vector_type(8)));
typedef short s16x4 __attribute__((ext_vector_type(4)));
using pg8::cvt_pk_bf16;
#define LDS_WAIT() asm volatile("s_waitcnt lgkmcnt(0)" ::: "memory")

__device__ __forceinline__ float bf2f(unsigned h) { return __builtin_bit_cast(float, h << 16); }
__device__ __forceinline__ float bflo(unsigned w) { return __builtin_bit_cast(float, w << 16); }
__device__ __forceinline__ float bfhi(unsigned w) { return __builtin_bit_cast(float, w & 0xffff0000u); }
__device__ __forceinline__ v4u pack8(f32x4 a, f32x4 b) { v4u w; w.x = cvt_pk_bf16(a[0], a[1]); w.y = cvt_pk_bf16(a[2], a[3]); w.z = cvt_pk_bf16(b[0], b[1]); w.w = cvt_pk_bf16(b[2], b[3]); return w; }
__device__ __forceinline__ void unpack8(v4u w, f32x4& a, f32x4& b) { a = (f32x4){bflo(w.x), bfhi(w.x), bflo(w.y), bfhi(w.y)}; b = (f32x4){bflo(w.z), bfhi(w.z), bflo(w.w), bfhi(w.w)}; }
__device__ __forceinline__ float wave_sum(float v) {
#pragma unroll
    for (int o = 1; o < 64; o <<= 1) v += __shfl_xor(v, o);
    return v;
}
__device__ __forceinline__ float silu_f(float x) { return x * __builtin_amdgcn_rcpf(1.0f + __builtin_amdgcn_exp2f(-1.4426950408889634f * x)); }
__device__ __forceinline__ float log2_gamma(int h) { return log2f(1.0f - exp2f(-5.0f - (float)h)); }

struct EpiInProj {
    static constexpr bool PERM = true, AFTER_DRAIN = false;
    bf16* P; const float* cs;
    __device__ __forceinline__ void operator()(const f32x4 (&acc)[2][2][4][2], const pg8::Unit& u, int wr, int wc, int fr, int fq) const {
        const int pn = u.pn, cgp = wc * 32 + 8 * fq, rowb = u.pm * 256 + wr * 64 + fr;
        if (pn < 4) {
            const int sec = pn >> 1, head = 2 * (pn & 1) + (cgp >> 6), dd = cgp & 63;
            const float sc = sec ? 0.08838834764831845f : 1.0f;
            const int oc = sec * 512 + head * 128 + dd;
#pragma unroll
            for (int ai = 0; ai < 2; ++ai)
#pragma unroll
                for (int m = 0; m < 4; ++m) {
                    const int row = rowb + ai * 128 + m * 16;
                    const int pidx = row < NPROMPT ? (row & (SEQ - 1)) : SEQ + (row & 7);
                    const float* t = cs + (size_t)pidx * 128 + dd;
                    const f32x4 c0 = *(const f32x4*)t, c1 = *(const f32x4*)(t + 4), s0 = *(const f32x4*)(t + 64), s1 = *(const f32x4*)(t + 68);
                    const f32x4 a0 = acc[ai][0][m][0], a1 = acc[ai][0][m][1], b0 = acc[ai][1][m][0], b1 = acc[ai][1][m][1];
                    bf16* o = P + (size_t)row * PROJW + oc;
                    *(v4u*)o = pack8((a0 * c0 - b0 * s0) * sc, (a1 * c1 - b1 * s1) * sc);
                    *(v4u*)(o + 64) = pack8((a0 * s0 + b0 * c0) * sc, (a1 * s1 + b1 * c1) * sc);
                }
        } else if (pn < 10) {
#pragma unroll
            for (int ai = 0; ai < 2; ++ai)
#pragma unroll
                for (int m = 0; m < 4; ++m) {
                    const int row = rowb + ai * 128 + m * 16;
                    bf16* o = P + (size_t)row * PROJW + pn * 256 + cgp;
                    *(v4u*)o = pack8(acc[ai][0][m][0], acc[ai][0][m][1]);
                    *(v4u*)(o + 128) = pack8(acc[ai][1][m][0], acc[ai][1][m][1]);
                }
        } else {
#pragma unroll
            for (int ai = 0; ai < 2; ++ai)
#pragma unroll
                for (int m = 0; m < 4; ++m) {
                    const int row = rowb + ai * 128 + m * 16;
                    bf16* o = P + (size_t)row * PROJW + 2560 + (pn - 10) * 128 + cgp;
                    *(v4u*)o = pack8(acc[ai][0][m][0] * acc[ai][1][m][0], acc[ai][0][m][1] * acc[ai][1][m][1]);
                }
        }
    }
};
struct EpiOut {
    static constexpr bool PERM = true, AFTER_DRAIN = false;
    const float* xp; const float* xs; float* x1; bf16* h2; const float* g2; float* ss2;
    __device__ __forceinline__ void operator()(const f32x4 (&acc)[2][2][4][2], const pg8::Unit& u, int wr, int wc, int fr, int fq) const {
        const int cgp = wc * 32 + 8 * fq, rowb = u.pm * 256 + wr * 64 + fr;
#pragma unroll
        for (int ai = 0; ai < 2; ++ai)
#pragma unroll
            for (int m = 0; m < 4; ++m) {
                const int row = rowb + ai * 128 + m * 16;
                const float* xr = row < NPROMPT ? xp + (size_t)row * DM : xs + (size_t)(row - NPROMPT) * DM;
                float ss = 0.f;
#pragma unroll
                for (int bj = 0; bj < 2; ++bj) {
                    const int col = u.pn * 256 + bj * 128 + cgp;
                    const f32x4 v0 = acc[ai][bj][m][0] + *(const f32x4*)(xr + col), v1 = acc[ai][bj][m][1] + *(const f32x4*)(xr + col + 4);
                    float* o = x1 + (size_t)row * DM + col;
                    *(f32x4*)o = v0; *(f32x4*)(o + 4) = v1;
                    ss += (v0[0] * v0[0] + v0[1] * v0[1]) + (v0[2] * v0[2] + v0[3] * v0[3]) + (v1[0] * v1[0] + v1[1] * v1[1]) + (v1[2] * v1[2] + v1[3] * v1[3]);
                    const f32x4 g0 = *(const f32x4*)(g2 + col), g1 = *(const f32x4*)(g2 + col + 4);
                    *(v4u*)(h2 + (size_t)row * DM + col) = pack8(v0 * g0, v1 * g1);
                }
                ss += __shfl_xor(ss, 16); ss += __shfl_xor(ss, 32);
                if (fq == 0) ss2[(size_t)row * 16 + u.pn * 4 + wc] = ss;
            }
    }
};
struct EpiGU {
    static constexpr bool PERM = true, AFTER_DRAIN = false;
    const float* ss2; bf16* act;
    __device__ __forceinline__ void operator()(const f32x4 (&acc)[2][2][4][2], const pg8::Unit& u, int wr, int wc, int fr, int fq) const {
        const int cgp = wc * 32 + 8 * fq, rowb = u.pm * 256 + wr * 64 + fr;
#pragma unroll
        for (int ai = 0; ai < 2; ++ai)
#pragma unroll
            for (int m = 0; m < 4; ++m) {
                const int row = rowb + ai * 128 + m * 16;
                const f32x4* sp = (const f32x4*)(ss2 + (size_t)row * 16);
                const f32x4 p0 = sp[0], p1 = sp[1], p2 = sp[2], p3 = sp[3];
                const f32x4 ps = (p0 + p1) + (p2 + p3);
                const float r = rsqrtf(((ps[0] + ps[1]) + (ps[2] + ps[3])) * (1.0f / DM) + 1e-6f);
                f32x4 o[2];
#pragma unroll
                for (int n = 0; n < 2; ++n) {
                    const f32x4 g = acc[ai][0][m][n] * r, up = acc[ai][1][m][n] * r;
                    o[n] = (f32x4){silu_f(g[0]) * up[0], silu_f(g[1]) * up[1], silu_f(g[2]) * up[2], silu_f(g[3]) * up[3]};
                }
                *(v4u*)(act + (size_t)row * FF + u.pn * 128 + cgp) = pack8(o[0], o[1]);
            }
    }
};
struct EpiDown {
    static constexpr bool PERM = true, AFTER_DRAIN = false;
    float* io;
    __device__ __forceinline__ void operator()(const f32x4 (&acc)[2][2][4][2], const pg8::Unit& u, int wr, int wc, int fr, int fq) const {
        const int cgp = wc * 32 + 8 * fq, rowb = u.pm * 256 + wr * 64 + fr;
#pragma unroll
        for (int ai = 0; ai < 2; ++ai)
#pragma unroll
            for (int m = 0; m < 4; ++m) {
                const int row = rowb + ai * 128 + m * 16;
#pragma unroll
                for (int bj = 0; bj < 2; ++bj) {
                    float* o = io + (size_t)row * DM + u.pn * 256 + bj * 128 + cgp;
                    const f32x4 v0 = acc[ai][bj][m][0] + *(const f32x4*)o, v1 = acc[ai][bj][m][1] + *(const f32x4*)(o + 4);
                    *(f32x4*)o = v0; *(f32x4*)(o + 4) = v1;
                }
            }
    }
};

__device__ __forceinline__ unsigned off_b(unsigned row, unsigned ch) { return 256u * row + 16u * (ch ^ (((row & 3u) << 2) | ((row >> 2) & 3u))); }
__device__ __forceinline__ unsigned row_addr16(unsigned lane, unsigned rb, unsigned s) { return off_b((lane & 15u) + 16u * rb, 4u * s + (lane >> 4)); }
__device__ __forceinline__ unsigned tr_addr16(unsigned lane, unsigned c, unsigned ks, unsigned t) {
    const unsigned g = lane >> 4, q = (lane & 15u) >> 2, p = lane & 3u;
    return off_b(32u * ks + 8u * g + 4u * t + q, 2u * c + (p >> 1)) + 8u * (p & 1u);
}
__device__ __forceinline__ void tr_frags4(unsigned img, unsigned lane, unsigned c, bf16x8 (&f)[4]) {
    const unsigned a0 = img + tr_addr16(lane, c, 0, 0), a1 = img + tr_addr16(lane, c, 0, 1);
    s16x4 r0, r1, r2, r3, r4, r5, r6, r7;
    asm volatile("ds_read_b64_tr_b16 %0, %8\n\t"
                 "ds_read_b64_tr_b16 %1, %9\n\t"
                 "ds_read_b64_tr_b16 %2, %8 offset:8192\n\t"
                 "ds_read_b64_tr_b16 %3, %9 offset:8192\n\t"
                 "ds_read_b64_tr_b16 %4, %8 offset:16384\n\t"
                 "ds_read_b64_tr_b16 %5, %9 offset:16384\n\t"
                 "ds_read_b64_tr_b16 %6, %8 offset:24576\n\t"
                 "ds_read_b64_tr_b16 %7, %9 offset:24576\n\t"
                 "s_waitcnt lgkmcnt(0)"
                 : "=&v"(r0), "=&v"(r1), "=&v"(r2), "=&v"(r3), "=&v"(r4), "=&v"(r5), "=&v"(r6), "=&v"(r7)
                 : "v"(a0), "v"(a1) : "memory");
    f[0] = (bf16x8){r0[0], r0[1], r0[2], r0[3], r1[0], r1[1], r1[2], r1[3]};
    f[1] = (bf16x8){r2[0], r2[1], r2[2], r2[3], r3[0], r3[1], r3[2], r3[3]};
    f[2] = (bf16x8){r4[0], r4[1], r4[2], r4[3], r5[0], r5[1], r5[2], r5[3]};
    f[3] = (bf16x8){r6[0], r6[1], r6[2], r6[3], r7[0], r7[1], r7[2], r7[3]};
}
#define MFMA16(a, b, c) __builtin_amdgcn_mfma_f32_16x16x32_bf16((a), (b), (c), 0, 0, 0)

template <bool SCALE>
__device__ __forceinline__ void stage_tile(LAS unsigned char* img, const bf16* src, size_t pitch, int tid, float zl) {
    v4u v[4];
#pragma unroll
    for (int k = 0; k < 4; ++k) { const int id = tid + 512 * k, row = id >> 4, ch = id & 15; v[k] = *(const v4u*)(src + (size_t)row * pitch + ch * 8); }
#pragma unroll
    for (int k = 0; k < 4; ++k) { const int id = tid + 512 * k, row = id >> 4, ch = id & 15;
        v4u w = v[k];
        if (SCALE) { f32x4 a, b; unpack8(w, a, b); const float z = __builtin_amdgcn_exp2f((float)(127 - row) * zl); w = pack8(a * z, b * z); }
        *(LAS v4u*)(img + off_b(row, ch)) = w; }
}

__device__ __forceinline__ void kv_unit(LAS unsigned char* lds, const bf16* proj, float* kv, int unit, int tid) {
    const int b = unit >> 6, h = (unit >> 4) & 3, c = unit & 15, row0 = b * SEQ + c * 128;
    const int lane = tid & 63, w = __builtin_amdgcn_readfirstlane(tid >> 6), fr = lane & 15, fq = lane >> 4;
    const float l2g = log2_gamma(h);
    LAS unsigned char* Kimg = lds; LAS unsigned char* Vimg = lds + 32768;
    stage_tile<true>(Kimg, proj + (size_t)row0 * PROJW + 512 + h * 128, PROJW, tid, l2g);
    stage_tile<false>(Vimg, proj + (size_t)row0 * PROJW + 1024 + h * 128, PROJW, tid, 0.f);
    __syncthreads();
    bf16x8 aK[4]; tr_frags4((unsigned)(size_t)Kimg, lane, w, aK);
    float* o = kv + (size_t)unit * 16384 + (size_t)(16 * w + 4 * fq) * 128 + fr;
#pragma unroll
    for (int nb = 0; nb < 8; ++nb) {
        bf16x8 bV[4]; tr_frags4((unsigned)(size_t)Vimg, lane, nb, bV);
        f32x4 acc = {0.f, 0.f, 0.f, 0.f};
#pragma unroll
        for (int s = 0; s < 4; ++s) acc = MFMA16(aK[s], bV[s], acc);
#pragma unroll
        for (int e = 0; e < 4; ++e) o[e * 128 + nb * 16] = acc[e];
    }
    __syncthreads();
}

__device__ __forceinline__ void sample_unit(LAS unsigned char* lds, const bf16* proj, const float* state_ret, const float* gn_g, bf16* mix, float* new_ret, int unit, int tid) {
    const int b = unit >> 2, h = unit & 3, row0 = NPROMPT + b * 8;
    const int lane = tid & 63, w = __builtin_amdgcn_readfirstlane(tid >> 6);
    LAS float* qT = (LAS float*)lds;
    LAS float* kzT = qT + 1024;
    LAS float* kT = kzT + 1024;
    LAS float* vs = kT + 1024;
    LAS float* sc = vs + 1024;
    LAS float* po = sc + 64;
    const float l2g = log2_gamma(h);
#pragma unroll
    for (int k2 = 0; k2 < 2; ++k2) {
        const int e = tid + 512 * k2, i = e >> 7, d = e & 127;
        const bf16* base = proj + (size_t)(row0 + i) * PROJW + h * 128 + d;
        const float q = bf2f(base[0]), k = bf2f(base[512]), v = bf2f(base[1024]);
        qT[d * 8 + i] = q; kT[d * 8 + i] = k; kzT[d * 8 + i] = k * __builtin_amdgcn_exp2f((float)(7 - i) * l2g); vs[i * 128 + d] = v;
    }
    __syncthreads();
    if (tid < 64) {
        const int i = tid >> 3, j = tid & 7; float s = 0.f;
        for (int d = 0; d < 128; ++d) s += qT[d * 8 + i] * kT[d * 8 + j];
        sc[i * 8 + j] = (j <= i) ? s * __builtin_amdgcn_exp2f((float)(i - j) * l2g) : 0.f;
    }
    const int v4 = (tid & 31) * 4, dg = tid >> 5;
    f32x4 vv[8], pacc[8];
#pragma unroll
    for (int j = 0; j < 8; ++j) { vv[j] = *(const LAS f32x4*)(vs + j * 128 + v4); pacc[j] = (f32x4){0.f, 0.f, 0.f, 0.f}; }
    const float g8 = __builtin_amdgcn_exp2f(8.0f * l2g);
    const float* Rin = state_ret + (size_t)(b * 4 + h) * 16384 + v4;
    float* Rout = new_ret + (size_t)(b * 4 + h) * 16384 + v4;
    f32x4 rr[8];
#pragma unroll
    for (int dd = 0; dd < 8; ++dd) rr[dd] = *(const f32x4*)(Rin + (size_t)(dg * 8 + dd) * 128);
#pragma unroll
    for (int dd = 0; dd < 8; ++dd) {
        const int d = dg * 8 + dd; const f32x4 r = rr[dd];
        const f32x4 q0 = *(const LAS f32x4*)(qT + d * 8), q1 = *(const LAS f32x4*)(qT + d * 8 + 4);
        const f32x4 z0 = *(const LAS f32x4*)(kzT + d * 8), z1 = *(const LAS f32x4*)(kzT + d * 8 + 4);
        f32x4 rn = r * g8;
#pragma unroll
        for (int i = 0; i < 4; ++i) { pacc[i] += r * q0[i]; pacc[4 + i] += r * q1[i]; rn += vv[i] * z0[i]; rn += vv[4 + i] * z1[i]; }
        *(f32x4*)(Rout + (size_t)d * 128) = rn;
    }
#pragma unroll
    for (int i = 0; i < 8; ++i) {
#pragma unroll
        for (int k = 0; k < 4; ++k) pacc[i][k] += __shfl_xor(pacc[i][k], 32);
        if (lane < 32) *(LAS f32x4*)(po + (w * 8 + i) * 128 + v4) = pacc[i];
    }
    __syncthreads();
    {
        const int i = w, v = lane * 2;
        float o0 = 0.f, o1 = 0.f;
#pragma unroll
        for (int ww = 0; ww < 8; ++ww) { o0 += po[(ww * 8 + i) * 128 + v]; o1 += po[(ww * 8 + i) * 128 + v + 1]; }
        const float xi = __builtin_amdgcn_exp2f((float)(i + 1) * l2g);
        o0 *= xi; o1 *= xi;
#pragma unroll
        for (int j = 0; j < 8; ++j) { const float s = sc[i * 8 + j]; o0 += s * vs[j * 128 + v]; o1 += s * vs[j * 128 + v + 1]; }
        const float mean = wave_sum(o0 + o1) * (1.0f / 128.0f);
        const float d0 = o0 - mean, d1 = o1 - mean;
        const float var = wave_sum(d0 * d0 + d1 * d1) * (1.0f / 128.0f);
        const float rstd = rsqrtf(var + 1e-5f);
        const unsigned gw = *(const unsigned*)(proj + (size_t)(row0 + i) * PROJW + 1536 + h * 128 + v);
        const float y0 = silu_f(bflo(gw)) * (d0 * rstd * gn_g[h * 128 + v]), y1 = silu_f(bfhi(gw)) * (d1 * rstd * gn_g[h * 128 + v + 1]);
        *(unsigned*)(mix + (size_t)(row0 + i) * DM + h * 128 + v) = cvt_pk_bf16(y0, y1);
    }
    __syncthreads();
}

__device__ __forceinline__ void conv_unit(const bf16* proj, const float* state_conv, const float* conv_w, bf16* mix, float* ncp, float* ncs, int unit, int tid) {
    const int cgp = (tid & 63) * 8, w = tid >> 6;
    const f32x4 w0a = *(const f32x4*)(conv_w + cgp), w0b = *(const f32x4*)(conv_w + cgp + 4);
    const f32x4 w1a = *(const f32x4*)(conv_w + 512 + cgp), w1b = *(const f32x4*)(conv_w + 512 + cgp + 4);
    const f32x4 w2a = *(const f32x4*)(conv_w + 1024 + cgp), w2b = *(const f32x4*)(conv_w + 1024 + cgp + 4);
#pragma unroll
    for (int rr = 0; rr < 4; ++rr) {
        const int m = unit * 32 + w + 8 * rr;
        const bool samp = m >= NPROMPT;
        const int l = samp ? (m & 7) : (m & (SEQ - 1)), bb = samp ? ((m - NPROMPT) >> 3) : (m >> 11);
        const bf16* pr = proj + (size_t)m * PROJW + cgp;
        f32x4 u2a, u2b, ga, gb, u1a, u1b, u0a, u0b;
        unpack8(*(const v4u*)(pr + 2560), u2a, u2b);
        unpack8(*(const v4u*)(pr + 2048), ga, gb);
        const f32x4 zero = {0.f, 0.f, 0.f, 0.f};
        if (l >= 1) unpack8(*(const v4u*)(pr + 2560 - PROJW), u1a, u1b);
        else if (samp) { const float* s = state_conv + (size_t)(bb * 2 + 1) * 512 + cgp; u1a = *(const f32x4*)s; u1b = *(const f32x4*)(s + 4); }
        else { u1a = zero; u1b = zero; }
        if (l >= 2) unpack8(*(const v4u*)(pr + 2560 - 2 * PROJW), u0a, u0b);
        else if (samp) { const float* s = state_conv + (size_t)(bb * 2 + l) * 512 + cgp; u0a = *(const f32x4*)s; u0b = *(const f32x4*)(s + 4); }
        else { u0a = zero; u0b = zero; }
        const f32x4 ya = w0a * u0a + w1a * u1a + w2a * u2a, yb = w0b * u0b + w1b * u1b + w2b * u2b;
        *(v4u*)(mix + (size_t)m * DM + 512 + cgp) = pack8(ga * ya, gb * yb);
        const int L = samp ? 8 : SEQ;
        if (l >= L - 2) { float* d = (samp ? ncs : ncp) + (size_t)(bb * 2 + (l - (L - 2))) * 512 + cgp; *(f32x4*)d = u2a; *(f32x4*)(d + 4) = u2b; }
    }
}

__device__ __forceinline__ void ro_unit(LAS unsigned char* lds, const bf16* proj, const bf16* rs, const float* gn_g, bf16* mix, int unit, int tid) {
    const int b = unit >> 6, h = (unit >> 4) & 3, c = unit & 15, row0 = b * SEQ + c * 128;
    const int lane = tid & 63, w = __builtin_amdgcn_readfirstlane(tid >> 6), fr = lane & 15, fq = lane >> 4;
    const float l2g = log2_gamma(h);
    LAS unsigned char* Qimg = lds; LAS unsigned char* Kimg = lds + 32768; LAS unsigned char* Vimg = lds + 65536; LAS unsigned char* Rimg = lds + 98304;
    const bf16* pb = proj + (size_t)row0 * PROJW + h * 128;
    stage_tile<false>(Qimg, pb, PROJW, tid, 0.f);
    stage_tile<false>(Kimg, pb + 512, PROJW, tid, 0.f);
    stage_tile<false>(Vimg, pb + 1024, PROJW, tid, 0.f);
    stage_tile<false>(Rimg, rs + (size_t)unit * 16384, 128, tid, 0.f);
    __syncthreads();
    bf16x8 aQ[4];
#pragma unroll
    for (int s = 0; s < 4; ++s) aQ[s] = *(const LAS bf16x8*)(Qimg + row_addr16(lane, w, s));
    f32x4 accI[8], accO[8];
#pragma unroll
    for (int nb = 0; nb < 8; ++nb) {
        bf16x8 bR[4]; tr_frags4((unsigned)(size_t)Rimg, lane, nb, bR);
        f32x4 a = {0.f, 0.f, 0.f, 0.f};
#pragma unroll
        for (int s = 0; s < 4; ++s) a = MFMA16(aQ[s], bR[s], a);
        accI[nb] = a;
    }
    const int il = 16 * w + fr;
#pragma unroll
    for (int jb = 0; jb < 8; ++jb) {
        v2u pw = {0u, 0u};
        if (jb <= w) {
            f32x4 a = {0.f, 0.f, 0.f, 0.f};
#pragma unroll
            for (int s = 0; s < 4; ++s) { const bf16x8 kf = *(const LAS bf16x8*)(Kimg + row_addr16(lane, jb, s)); a = MFMA16(kf, aQ[s], a); }
            float p[4];
#pragma unroll
            for (int e = 0; e < 4; ++e) { const int dlt = il - (16 * jb + 4 * fq + e); p[e] = dlt >= 0 ? a[e] * __builtin_amdgcn_exp2f((float)dlt * l2g) : 0.f; }
            pw.x = cvt_pk_bf16(p[0], p[1]); pw.y = cvt_pk_bf16(p[2], p[3]);
        }
        *(LAS v2u*)(Qimg + off_b(il, 2 * jb + (fq >> 1)) + 8 * (fq & 1)) = pw;
    }
    bf16x8 aP[4];
#pragma unroll
    for (int s = 0; s < 4; ++s) aP[s] = *(const LAS bf16x8*)(Qimg + row_addr16(lane, w, s));
#pragma unroll
    for (int nb = 0; nb < 8; ++nb) {
        bf16x8 bV[4]; tr_frags4((unsigned)(size_t)Vimg, lane, nb, bV);
        f32x4 a = {0.f, 0.f, 0.f, 0.f};
#pragma unroll
        for (int s = 0; s < 4; ++s) a = MFMA16(aP[s], bV[s], a);
        accO[nb] = a;
    }
    float gg[8];
#pragma unroll
    for (int nb = 0; nb < 8; ++nb) gg[nb] = gn_g[h * 128 + nb * 16 + fr];
#pragma unroll
    for (int e = 0; e < 4; ++e) {
        const float xi = __builtin_amdgcn_exp2f((float)(16 * w + 4 * fq + e + 1) * l2g);
        float o[8], s = 0.f;
#pragma unroll
        for (int nb = 0; nb < 8; ++nb) { o[nb] = accO[nb][e] + xi * accI[nb][e]; s += o[nb]; }
        s += __shfl_xor(s, 1); s += __shfl_xor(s, 2); s += __shfl_xor(s, 4); s += __shfl_xor(s, 8);
        const float mean = s * (1.0f / 128.0f); float q = 0.f;
#pragma unroll
        for (int nb = 0; nb < 8; ++nb) { o[nb] -= mean; q += o[nb] * o[nb]; }
        q += __shfl_xor(q, 1); q += __shfl_xor(q, 2); q += __shfl_xor(q, 4); q += __shfl_xor(q, 8);
        const float rstd = rsqrtf(q * (1.0f / 128.0f) + 1e-5f);
        const unsigned ro = 16 * w + 4 * fq + e;
#pragma unroll
        for (int nb = 0; nb < 8; ++nb)
            *(LAS unsigned short*)(Qimg + off_b(ro, 2 * nb + (fr >> 3)) + 2 * (fr & 7)) = (unsigned short)(cvt_pk_bf16(o[nb] * rstd * gg[nb], 0.f) & 0xffffu);
    }
#pragma unroll
    for (int k = 0; k < 4; ++k) {
        const int id = lane + 64 * k, r = id >> 4, ch = id & 15;
        const v4u ov = *(const LAS v4u*)(Qimg + off_b(16 * w + r, ch));
        const size_t grow = (size_t)(row0 + 16 * w + r);
        const v4u gv = *(const v4u*)(proj + grow * PROJW + 1536 + h * 128 + ch * 8);
        f32x4 oa, ob, ga, gb; unpack8(ov, oa, ob); unpack8(gv, ga, gb);
        const f32x4 ya = {silu_f(ga[0]) * oa[0], silu_f(ga[1]) * oa[1], silu_f(ga[2]) * oa[2], silu_f(ga[3]) * oa[3]};
        const f32x4 yb = {silu_f(gb[0]) * ob[0], silu_f(gb[1]) * ob[1], silu_f(gb[2]) * ob[2], silu_f(gb[3]) * ob[3]};
        *(v4u*)(mix + grow * DM + h * 128 + ch * 8) = pack8(ya, yb);
    }
    __syncthreads();
}

#define RLX_AGENT __ATOMIC_RELAXED, __HIP_MEMORY_SCOPE_AGENT
#define XB_TMO      128
#define XB_XCNT(j)  (256  + 64 * (j))
#define XB_XSUB(j)  (1280 + 64 * (j))
#define XB_XGEN(j)  (2304 + 64 * (j))
#define XB_TOP      3328
#define XB_TOPGEN   3392
#define XCD_BAR_WORDS 3456
#define XB_SPIN_CAP (1u << 18)

__device__ __forceinline__ unsigned xb_ld(unsigned* p)              { return __hip_atomic_load(p, __ATOMIC_RELAXED, __HIP_MEMORY_SCOPE_AGENT); }
__device__ __forceinline__ unsigned xb_add(unsigned* p, unsigned v) { return __hip_atomic_fetch_add(p, v, __ATOMIC_RELAXED, __HIP_MEMORY_SCOPE_AGENT); }
__device__ __forceinline__ unsigned xb_xcc_id() { return (unsigned)__builtin_amdgcn_s_getreg((3 << 11) | 20) & 0xFu; }
#define XB_SPIN(cond, bar) do { unsigned _sp = 0; while (cond) { __builtin_amdgcn_s_sleep(1); \
    if ((++_sp & 255u) == 0u) { if (xb_ld(&(bar)[XB_TMO])) break; if (_sp > XB_SPIN_CAP) { atomicAdd(&(bar)[XB_TMO], 1u); break; } } } } while (0)

struct XcdBarrier {
    unsigned* bar; unsigned x;
    volatile LAS unsigned* st;
};

__device__ __forceinline__ XcdBarrier xcd_barrier_post(unsigned* bar, volatile LAS unsigned* st) {
    XcdBarrier b; b.bar = bar; b.x = xb_xcc_id(); b.st = st;
    if (threadIdx.x == 0) (void)xb_add(&bar[XB_XCNT(b.x)], 1u);
    return b;
}
__device__ __forceinline__ void xcd_barrier_complete(unsigned* bar, unsigned x, unsigned& nloc, unsigned& nx) {
    const unsigned G = gridDim.x * gridDim.y * gridDim.z;
    unsigned sum, cnt, mine, sp = 0u;
    for (;;) {
        sum = 0u; cnt = 0u; mine = 0u;
#pragma unroll
        for (unsigned j = 0; j < 16; ++j) { const unsigned c = xb_ld(&bar[XB_XCNT(j)]); sum += c; cnt += (c > 0u) ? 1u : 0u; mine = (j == x) ? c : mine; }
        if (sum == G) break;
        __builtin_amdgcn_s_sleep(1);
        if ((++sp & 255u) == 0u) { if (xb_ld(&bar[XB_TMO])) break; if (sp > XB_SPIN_CAP) { atomicAdd(&bar[XB_TMO], 1u); break; } }
    }
    nloc = mine > 0u ? mine : 1u; nx = cnt > 0u ? cnt : 1u;
}

__device__ __forceinline__ void xcd_barrier(const XcdBarrier& b) {
    asm volatile("s_waitcnt vmcnt(0)" ::: "memory");
    __syncthreads();
    if (threadIdx.x == 0) {
        unsigned* bar = b.bar;
        __builtin_amdgcn_s_waitcnt(0);
        unsigned nloc = b.st[0], nx = b.st[1];
        if (nloc == 0u) { xcd_barrier_complete(bar, b.x, nloc, nx); b.st[0] = nloc; b.st[1] = nx; }
        const unsigned old = xb_add(&bar[XB_XSUB(b.x)], 1u);
        const unsigned gen = old / nloc;
        if (old + 1u == (gen + 1u) * nloc) {
            __builtin_amdgcn_fence(__ATOMIC_RELEASE, "agent");
            asm volatile("s_waitcnt vmcnt(0)" ::: "memory");
            const unsigned og = xb_add(&bar[XB_TOP], 1u);
            const unsigned tg = og / nx;
            if (og + 1u == (tg + 1u) * nx) xb_add(&bar[XB_TOPGEN], 1u);
            else XB_SPIN(xb_ld(&bar[XB_TOPGEN]) == tg, bar);
            __builtin_amdgcn_fence(__ATOMIC_ACQUIRE, "agent");
            xb_add(&bar[XB_XGEN(b.x)], 1u);
            asm volatile("s_waitcnt vmcnt(0)" ::: "memory");
        } else {
            XB_SPIN(xb_ld(&bar[XB_XGEN(b.x)]) == gen, bar);
            __builtin_amdgcn_fence(__ATOMIC_ACQUIRE, "agent");
            asm volatile("s_waitcnt vmcnt(0)" ::: "memory");
        }
    }
    __syncthreads();
}

template <int MODE>
__device__ __forceinline__ void small_gemm_unit(LAS unsigned char* lds, const bf16* A, const bf16* Bt, const int K, const int row0, const int col0,
                                                const float* xs, float* io, bf16* h2, const float* g2, float* ss2, int tid) {
    const int lane = tid & 63, w = __builtin_amdgcn_readfirstlane(tid >> 6), fr = lane & 15, fq = lane >> 4;
    const int nks = K >> 5;
    f32x4 acc[2][8];
#pragma unroll
    for (int mb = 0; mb < 2; ++mb)
#pragma unroll
        for (int nb = 0; nb < 8; ++nb) acc[mb][nb] = (f32x4){0.f, 0.f, 0.f, 0.f};
    const bf16* ap = A + (size_t)(row0 + fr) * K + 8 * fq + 32 * w;
    const bf16* bp = Bt + (size_t)(col0 + fr) * K + 8 * fq + 32 * w;
    bf16x8 a[2], b[8];
#pragma unroll
    for (int mb = 0; mb < 2; ++mb) a[mb] = *(const bf16x8*)(ap + (size_t)mb * 16 * K);
#pragma unroll
    for (int nb = 0; nb < 8; ++nb) b[nb] = *(const bf16x8*)(bp + (size_t)nb * 16 * K);
    for (int s = w; s < nks; s += 8) {
        const bool more = (s + 8) < nks;
        bf16x8 an[2], bn[8];
        ap += 256; bp += 256;
        if (more) {
#pragma unroll
            for (int mb = 0; mb < 2; ++mb) an[mb] = *(const bf16x8*)(ap + (size_t)mb * 16 * K);
#pragma unroll
            for (int nb = 0; nb < 8; ++nb) bn[nb] = *(const bf16x8*)(bp + (size_t)nb * 16 * K);
        }
#pragma unroll
        for (int mb = 0; mb < 2; ++mb)
#pragma unroll
            for (int nb = 0; nb < 8; ++nb) acc[mb][nb] = MFMA16(b[nb], a[mb], acc[mb][nb]);
        if (more) {
#pragma unroll
            for (int mb = 0; mb < 2; ++mb) a[mb] = an[mb];
#pragma unroll
            for (int nb = 0; nb < 8; ++nb) b[nb] = bn[nb];
        }
    }
    constexpr int PST = 132;
    LAS float* part = (LAS float*)lds + w * (32 * PST);
#pragma unroll
    for (int mb = 0; mb < 2; ++mb)
#pragma unroll
        for (int nb = 0; nb < 8; ++nb) *(LAS f32x4*)(part + (16 * mb + fr) * PST + 16 * nb + 4 * fq) = acc[mb][nb];
    __syncthreads();
    const int r = tid >> 4, c8 = (tid & 15) * 8;
    f32x4 s0 = {0.f, 0.f, 0.f, 0.f}, s1 = {0.f, 0.f, 0.f, 0.f};
#pragma unroll
    for (int ww = 0; ww < 8; ++ww) { const LAS float* p = (const LAS float*)lds + ww * (32 * PST) + r * PST + c8; s0 += *(const LAS f32x4*)p; s1 += *(const LAS f32x4*)(p + 4); }
    const int row = row0 + r, col = col0 + c8;
    float* o = io + (size_t)row * DM + col;
    if (MODE == 0) {
        const float* xr = xs + (size_t)(row - NPROMPT) * DM + col;
        const f32x4 v0 = s0 + *(const f32x4*)xr, v1 = s1 + *(const f32x4*)(xr + 4);
        *(f32x4*)o = v0; *(f32x4*)(o + 4) = v1;
        float ss = (v0[0] * v0[0] + v0[1] * v0[1]) + (v0[2] * v0[2] + v0[3] * v0[3]) + (v1[0] * v1[0] + v1[1] * v1[1]) + (v1[2] * v1[2] + v1[3] * v1[3]);
        const f32x4 g0 = *(const f32x4*)(g2 + col), g1 = *(const f32x4*)(g2 + col + 4);
        *(v4u*)(h2 + (size_t)row * DM + col) = pack8(v0 * g0, v1 * g1);
        ss += __shfl_xor(ss, 1); ss += __shfl_xor(ss, 2); ss += __shfl_xor(ss, 4); ss += __shfl_xor(ss, 8);
        if ((tid & 15) == 0) { float* sp = ss2 + (size_t)row * 16 + 2 * (col0 >> 7); sp[0] = ss; sp[1] = 0.f; }
    } else {
        const f32x4 v0 = s0 + *(const f32x4*)o, v1 = s1 + *(const f32x4*)(o + 4);
        *(f32x4*)o = v0; *(f32x4*)(o + 4) = v1;
    }
    __syncthreads();
}

__device__ __forceinline__ void p0_transpose_item(const float* W, int K, int N, bf16* WT, int k0, int n0, int dst_row0, LAS float* scr, int lane) {
#pragma unroll 8
    for (int i = 0; i < 32; ++i) { const int kk = 2 * i + (lane >> 5); scr[kk * 33 + (lane & 31)] = W[(size_t)(k0 + kk) * N + n0 + (lane & 31)]; }
    LDS_WAIT(); asm volatile("" ::: "memory");
    const int c = lane & 7;
#pragma unroll
    for (int j = 0; j < 4; ++j) { const int n = (lane >> 3) + 8 * j; const LAS float* s = scr + (8 * c) * 33 + n;
        v4u o; o.x = cvt_pk_bf16(s[0 * 33], s[1 * 33]); o.y = cvt_pk_bf16(s[2 * 33], s[3 * 33]); o.z = cvt_pk_bf16(s[4 * 33], s[5 * 33]); o.w = cvt_pk_bf16(s[6 * 33], s[7 * 33]);
        *(v4u*)(WT + (size_t)(dst_row0 + n) * K + k0 + 8 * c) = o; }
    LDS_WAIT(); asm volatile("" ::: "memory");
}
__device__ __forceinline__ int win_dst(int s) {
    if (s < 1024) { const int sec = s >> 9, hh = (s & 511) >> 7, dpos = s & 127; return (sec * 2 + (hh >> 1)) * 256 + (dpos >> 6) * 128 + (hh & 1) * 64 + (dpos & 63); }
    if (s < 2560) return s;
    if (s < 3072) { const int i = s - 2560; return (10 + (i >> 7)) * 256 + (i & 127); }
    const int i = s - 3072; return (10 + (i >> 7)) * 256 + 128 + (i & 127);
}

struct Args { const float* in[14]; float* out; unsigned char* ws; int lo, hi; };

__global__ void __launch_bounds__(NWAVES * 64, 2) mk_fwd(Args a) {
    extern __shared__ __attribute__((aligned(16))) unsigned char lds_raw[];
    LAS unsigned char* lds = (LAS unsigned char*)lds_raw;
    const int tid = threadIdx.x, lane = tid & 63, wave = __builtin_amdgcn_readfirstlane(tid >> 6);
    const int G = gridDim.x, bx = blockIdx.x;
    const int lo = a.lo, hi = a.hi;
    const float *x_prompt = a.in[0], *x_sample = a.in[1], *state_conv = a.in[2], *state_ret = a.in[3], *norm1_g = a.in[4], *w_in = a.in[5], *conv_w = a.in[6],
                *ret_gn_g = a.in[7], *w_out = a.in[8], *norm2_g = a.in[9], *w_gate = a.in[10], *w_up = a.in[11], *w_down = a.in[12], *norm_f_g = a.in[13];
    unsigned char* ws = a.ws; float* out = a.out;
    bf16* Wt_in = (bf16*)(ws + WS_WIN); bf16* Wt_out = (bf16*)(ws + WS_WOUT); bf16* Wt_gu = (bf16*)(ws + WS_WGU); bf16* Wt_dn = (bf16*)(ws + WS_WDN);
    float* CS = (float*)(ws + WS_CS); float* SS2 = (float*)(ws + WS_SS2);
    bf16* XN = (bf16*)(ws + WS_XN); bf16* PROJ = (bf16*)(ws + WS_PROJ); bf16* ACT = (bf16*)(ws + WS_PROJ);
    float* KV = (float*)(ws + WS_KV); bf16* RS = (bf16*)(ws + WS_RS); bf16* MIX = (bf16*)(ws + WS_MIX);
#define IN(k) (lo <= (k) && (k) < hi)
    XcdBarrier bar; bar.bar = (unsigned*)(ws + WS_CTL); bar.x = 0; bar.st = nullptr;
    if (hi - lo > 1) {
        volatile LAS unsigned* misc = (volatile LAS unsigned*)(lds + MISC_OFF);
        if (tid < 32) misc[tid] = 0u;
        __syncthreads();
        bar = xcd_barrier_post((unsigned*)(ws + WS_CTL), misc + 8);
    }
#define SEAM(k) do { if (IN(k) && IN((k) + 1)) { xcd_barrier(bar); } } while (0)

    if (IN(0)) {
        LAS float* scr = (LAS float*)(lds + wave * 16384);
        const int gw = bx * NWAVES + wave, NGW = G * NWAVES;
        constexpr int I_IN = 16 * (NIN / 32), I_OUT = 16 * 32, I_G = 16 * (FF / 32), I_DN = (FF / 64) * 32;
        constexpr int NITEMS = I_IN + I_OUT + 2 * I_G + I_DN;
        for (int it = gw; it < NITEMS; it += NGW) {
            int r = it;
            if (r < I_IN) { const int kb = r / (NIN / 32), nb = r % (NIN / 32); p0_transpose_item(w_in, DM, NIN, Wt_in, 64 * kb, 32 * nb, win_dst(32 * nb), scr, lane); continue; } r -= I_IN;
            if (r < I_OUT) { const int kb = r / 32, nb = r % 32; p0_transpose_item(w_out, DM, DM, Wt_out, 64 * kb, 32 * nb, 32 * nb, scr, lane); continue; } r -= I_OUT;
            if (r < I_G) { const int kb = r / (FF / 32), nb = r % (FF / 32), s = 32 * nb; p0_transpose_item(w_gate, DM, FF, Wt_gu, 64 * kb, s, (s >> 7) * 256 + (s & 127), scr, lane); continue; } r -= I_G;
            if (r < I_G) { const int kb = r / (FF / 32), nb = r % (FF / 32), s = 32 * nb; p0_transpose_item(w_up, DM, FF, Wt_gu, 64 * kb, s, (s >> 7) * 256 + 128 + (s & 127), scr, lane); continue; } r -= I_G;
            { const int kb = r / 32, nb = r % 32; p0_transpose_item(w_down, FF, DM, Wt_dn, 64 * kb, 32 * nb, 32 * nb, scr, lane); }
        }
        for (int m = gw; m < M; m += NGW) {
            const float* xrow = m < NPROMPT ? x_prompt + (size_t)m * DM : x_sample + (size_t)(m - NPROMPT) * DM;
            const f32x4* xr = (const f32x4*)xrow + lane; f32x4 v[4]; float s = 0.f;
#pragma unroll
            for (int j = 0; j < 4; ++j) { v[j] = xr[64 * j]; s += (v[j][0] * v[j][0] + v[j][1] * v[j][1]) + (v[j][2] * v[j][2] + v[j][3] * v[j][3]); }
            const float r = rsqrtf(wave_sum(s) * (1.0f / DM) + 1e-6f);
            v2u* o8 = (v2u*)(XN + (size_t)m * DM) + lane;
#pragma unroll
            for (int j = 0; j < 4; ++j) { const f32x4 g = ((const f32x4*)norm1_g)[lane + 64 * j]; const f32x4 y = v[j] * r * g; v2u wv; wv.x = cvt_pk_bf16(y[0], y[1]); wv.y = cvt_pk_bf16(y[2], y[3]); o8[64 * j] = wv; }
        }
        for (int e = bx * 512 + tid; e < (SEQ + 8) * 64; e += G * 512) {
            const int p = e >> 6, i = e & 63;
            const double pos = p < SEQ ? (double)p : (double)(16384 + (p - SEQ));
            const double inv = exp2(-(double)i * (13.287712379549449 / 64.0));
            const double rev = pos * inv * 0.15915494309189535;
            const float fr_ = (float)(rev - floor(rev));
            CS[(size_t)p * 128 + i] = __builtin_amdgcn_cosf(fr_); CS[(size_t)p * 128 + 64 + i] = __builtin_amdgcn_sinf(fr_);
        }
    }
    SEAM(0);
    if (IN(1)) {
        pg8::Gemm g{XN, Wt_in, M, NIN, DM}; pg8::StaticOrder S; S.init(M, NIN, G, bx);
        EpiInProj E{PROJ, CS};
        pg8::gemm_phase<EpiInProj, pg8::StaticOrder, true, true>(lds, g, S, E);
    }
    SEAM(1);
    if (IN(2)) {
        for (int it = bx; it < 512; it += G) kv_unit(lds, PROJ, KV, it, tid);
        for (int it = bx; it < 512; it += G) sample_unit(lds, PROJ, state_ret, ret_gn_g, MIX, out + OUT_NRS, it, tid);
        for (int it = bx; it < M / 32; it += G) conv_unit(PROJ, state_conv, conv_w, MIX, out + OUT_NCP, out + OUT_NCS, it, tid);
    }
    SEAM(2);
    if (IN(3)) {
        for (int e4 = bx * 512 + tid; e4 < 32 * 4096; e4 += G * 512) {
            const int bh = e4 >> 12, dv = (e4 & 4095) * 4, h = bh & 3;
            const float g128 = __builtin_amdgcn_exp2f(128.0f * log2_gamma(h));
            const float* kvp = KV + (size_t)bh * 16 * 16384 + dv; bf16* rp = RS + (size_t)bh * 16 * 16384 + dv;
            f32x4 kvv[16];
#pragma unroll
            for (int c = 0; c < 16; ++c) kvv[c] = *(const f32x4*)(kvp + (size_t)c * 16384);
            f32x4 r = {0.f, 0.f, 0.f, 0.f};
#pragma unroll
            for (int c = 0; c < 16; ++c) { v2u wv; wv.x = cvt_pk_bf16(r[0], r[1]); wv.y = cvt_pk_bf16(r[2], r[3]); *(v2u*)(rp + (size_t)c * 16384) = wv; r = r * g128 + kvv[c]; }
            *(f32x4*)(out + OUT_NRP + (size_t)bh * 16384 + dv) = r;
        }
    }
    SEAM(3);
    if (IN(4)) {
        for (int it = bx; it < 512; it += G) ro_unit(lds, PROJ, RS, ret_gn_g, MIX, it, tid);
    }
    SEAM(4);
    if (IN(5)) {
        pg8::Gemm g{MIX, Wt_out, NPROMPT, DM, DM}; pg8::StaticOrder S; S.init(NPROMPT, DM, G, bx);
        EpiOut E{x_prompt, x_sample, out + OUT_Y, XN, norm2_g, SS2};
        pg8::gemm_phase<EpiOut, pg8::StaticOrder, true, true>(lds, g, S, E);
        for (int it = bx; it < 256; it += G) small_gemm_unit<0>(lds, MIX, Wt_out, DM, NPROMPT + (it >> 3) * 32, (it & 7) * 128, x_sample, out + OUT_Y, XN, norm2_g, SS2, tid);
    }
    SEAM(5);
    if (IN(6)) {
        pg8::Gemm g{XN, Wt_gu, M, NGU, DM}; pg8::StaticOrder S; S.init(M, NGU, G, bx);
        EpiGU E{SS2, ACT};
        pg8::gemm_phase<EpiGU, pg8::StaticOrder, true, true>(lds, g, S, E);
    }
    SEAM(6);
    if (IN(7)) {
        pg8::Gemm g{ACT, Wt_dn, NPROMPT, DM, FF}; pg8::StaticOrder S; S.init(NPROMPT, DM, G, bx);
        EpiDown E{out + OUT_Y};
        pg8::gemm_phase<EpiDown, pg8::StaticOrder, true, true>(lds, g, S, E);
        for (int it = bx; it < 256; it += G) small_gemm_unit<1>(lds, ACT, Wt_dn, FF, NPROMPT + (it >> 3) * 32, (it & 7) * 128, nullptr, out + OUT_Y, nullptr, nullptr, nullptr, tid);
    }
    SEAM(7);
    if (IN(8)) {
        const int gw = bx * NWAVES + wave, NGW = G * NWAVES;
        for (int m = gw; m < M; m += NGW) {
            f32x4* xr = (f32x4*)(out + OUT_Y + (size_t)m * DM) + lane; f32x4 v[4]; float s = 0.f;
#pragma unroll
            for (int j = 0; j < 4; ++j) { v[j] = xr[64 * j]; s += (v[j][0] * v[j][0] + v[j][1] * v[j][1]) + (v[j][2] * v[j][2] + v[j][3] * v[j][3]); }
            const float r = rsqrtf(wave_sum(s) * (1.0f / DM) + 1e-6f);
#pragma unroll
            for (int j = 0; j < 4; ++j) { const f32x4 g = ((const f32x4*)norm_f_g)[lane + 64 * j]; xr[64 * j] = v[j] * r * g; }
        }
    }
#undef IN
#undef SEAM
}

extern "C" void kernel_launch(void* const* d_in, const int* in_sizes, int n_in, void* d_out, int out_size, void* d_ws, size_t ws_size, hipStream_t stream) {
    static int grid = 0;
    if (grid == 0) {
        if (n_in != 14 || ws_size < WS_END) { fprintf(stderr, "kernel_launch: unexpected n_in %d / ws_size %zu\n", n_in, ws_size); grid = -1; return; }
        int dev = 0, cus = 0, per_cu = 0;
        if (hipGetDevice(&dev) != hipSuccess || hipDeviceGetAttribute(&cus, hipDeviceAttributeMultiprocessorCount, dev) != hipSuccess) { grid = -1; return; }
        if (hipFuncSetAttribute((const void*)mk_fwd, hipFuncAttributeMaxDynamicSharedMemorySize, LDS_BYTES) != hipSuccess) { fprintf(stderr, "kernel_launch: hipFuncSetAttribute failed\n"); grid = -1; return; }
        if (hipOccupancyMaxActiveBlocksPerMultiprocessor(&per_cu, (const void*)mk_fwd, NWAVES * 64, LDS_BYTES) != hipSuccess || per_cu < 1) { fprintf(stderr, "kernel_launch: occupancy query gave %d\n", per_cu); (void)hipGetLastError(); per_cu = 1; }
        grid = cus * per_cu;
    }
    if (grid < 0) return;
    if (hipMemsetAsync((char*)d_ws + WS_CTL, 0, CTL_BYTES, stream) != hipSuccess) { fprintf(stderr, "kernel_launch: memset failed\n"); return; }
    Args a{};
    for (int i = 0; i < 14; ++i) a.in[i] = (const float*)d_in[i];
    a.out = (float*)d_out; a.ws = (unsigned char*)d_ws;
#if MK_N_LAUNCHES == 1
    a.lo = 0; a.hi = NPHASE;
    void* args[] = {&a};
    hipError_t e = hipLaunchCooperativeKernel((const void*)mk_fwd, dim3(grid), dim3(NWAVES * 64), args, LDS_BYTES, stream);
    if (e != hipSuccess) fprintf(stderr, "kernel_launch: cooperative launch failed: %s (grid %d)\n", hipGetErrorString(e), grid);
#else
#ifdef MK_PROBE_SEQ
    const int seq[] = MK_PROBE_SEQ;
    for (int p : seq) {
#else
    for (int p = 0; p < NPHASE; ++p) {
#endif
        a.lo = p; a.hi = p + 1;
        hipLaunchKernelGGL(mk_fwd, dim3(grid), dim3(NWAVES * 64), LDS_BYTES, stream, a);
    }
#endif
}
```

```cpp
#include <hip/hip_runtime.h>
#include <hip/hip_cooperative_groups.h>
#include <cstdio>
#include <cstdint>
namespace cg = cooperative_groups;
#define MK_N_LAUNCHES 1
namespace pg8 {
#define PG8_LAS __attribute__((address_space(3)))
typedef unsigned short bf16_t;
typedef short bf16x8 __attribute__((ext_vector_type(8)));
typedef float f32x4 __attribute__((ext_vector_type(4)));
typedef unsigned u32x4 __attribute__((ext_vector_type(4)));
constexpr int BM = 256, BK = 64, HALF = 128, HTB = HALF * BK * 2  , STAGE_BYTES = 8 * HTB, NXCD = 8, WGM = 8;

__host__ __device__ __forceinline__ int lds_byte(int r, int c) { const int st = (r >> 4) * 2 + (c >> 5), rr = r & 15, cc = c & 31, ob = rr * 64 + cc * 2; return st * 1024 + (ob ^ (((ob >> 9) & 1) << 5)); }
__host__ __device__ __forceinline__ void stage_rc(int b, int& R, int& C) { const int st = b / 1024, sb = b % 1024, swz = sb ^ (((sb >> 9) & 1) << 5); R = (st >> 1) * 16 + swz / 64; C = (st & 1) * 32 + (swz % 64) / 2; }
__host__ __device__ __forceinline__ int perm32(int rho) { const int n = rho >> 4, i = rho & 15; return 8 * (i >> 2) + 4 * n + (i & 3); }

struct Unit { int pm, pn; };
struct Gemm { const bf16_t* A; const bf16_t* Bt; int M, N, K; };

struct StaticOrder {
    int nM, nN, nwg, G, c;
    __host__ __device__ void init(int M, int N, int G_, int c_) { nM = M / BM; nN = N / BM; nwg = nM * nN; G = G_; c = c_; }
    __host__ __device__ bool next(int i, Unit& u) const {
        const long L = (long)i * G + c; if (L >= nwg) return false;
        int wgid = (int)L; { const int q = nwg / NXCD, r = nwg % NXCD, xcd = wgid % NXCD, off = wgid / NXCD; wgid = (xcd < r ? xcd * (q + 1) : r * (q + 1) + (xcd - r) * q) + off; }
        const int nig = WGM * nN, gid = wgid / nig, fm = gid * WGM, gsz = (nM - fm) < WGM ? (nM - fm) : WGM;
        u.pm = fm + ((wgid % nig) % gsz); u.pn = (wgid % nig) / gsz; return true;
    }
    __device__ __forceinline__ void a_ready(const Unit&) const {}
    __device__ __forceinline__ void done(const Unit&) const {}
};

__device__ __forceinline__ unsigned cvt_pk_bf16(float lo, float hi) { unsigned r; asm volatile("v_cvt_pk_bf16_f32 %0, %1, %2" : "=v"(r) : "v"(lo), "v"(hi)); return r; }
template <class Epi, class Sched, bool ALIGN_EPI = false, bool SP2 = false>
__device__ __forceinline__ void gemm_phase(PG8_LAS unsigned char* lds, const Gemm g, const Sched& S, const Epi& E) {
    const int tid = threadIdx.x, wid = __builtin_amdgcn_readfirstlane(tid >> 6), lane = tid & 63, wr = wid >> 2, wc = wid & 3, fr = lane & 15, fq = lane >> 4;
    const int K = g.K, nt = K / BK;
    unsigned voffA[2], voffB[2];
#pragma unroll
    for (int i = 0; i < 2; ++i) { int R, C; stage_rc(tid * 16 + i * 8192, R, C); const int Rb = Epi::PERM ? ((R & ~31) + perm32(R & 31)) : R;
        voffA[i] = (unsigned)(R * K + C) * 2u; voffB[i] = (unsigned)(Rb * K + C) * 2u; }
    const size_t kstep = (size_t)(BK * 2);
    const size_t hstep = (size_t)HALF * K * 2;
    const size_t tstep = 2 * hstep;
    const unsigned ldsw = (unsigned)wid * 1024u;
    const int aoff = lds_byte(wr * 64 + fr, fq * 8), boff = lds_byte(wc * 32 + fr, fq * 8);
#define PG8_SA(b, h) (((b) * 2 + (h)) * HTB)
#define PG8_SB(b, h) ((4 + (b) * 2 + (h)) * HTB)
#define PG8_STAGE(bufoff, gbase, voff) do { _Pragma("unroll") for (int _i = 0; _i < 2; ++_i) \
        __builtin_amdgcn_global_load_lds((const unsigned*)((const char*)(gbase) + (voff)[_i]), (PG8_LAS unsigned*)(lds + (bufoff) + ldsw + _i * 8192), 16, 0, 0); } while (0)
#define PG8_LDA(dst, b, h) do { _Pragma("unroll") for (int m = 0; m < 4; ++m) _Pragma("unroll") for (int k = 0; k < 2; ++k) dst[m][k] = *(const PG8_LAS bf16x8*)(lds + PG8_SA(b, h) + aoff + m * 2048 + k * 1024); } while (0)
#define PG8_LDB(dst, b, h) do { _Pragma("unroll") for (int n = 0; n < 2; ++n) _Pragma("unroll") for (int k = 0; k < 2; ++k) dst[n][k] = *(const PG8_LAS bf16x8*)(lds + PG8_SB(b, h) + boff + n * 2048 + k * 1024); } while (0)
#define PG8_MMA(ai, bj, At, Bt) do { __builtin_amdgcn_s_setprio(1); _Pragma("unroll") for (int m = 0; m < 4; ++m) _Pragma("unroll") for (int n = 0; n < 2; ++n) _Pragma("unroll") for (int k = 0; k < 2; ++k) \
        acc[ai][bj][m][n] = __builtin_amdgcn_mfma_f32_16x16x32_bf16(Bt[n][k], At[m][k], acc[ai][bj][m][n], 0, 0, 0); __builtin_amdgcn_s_setprio(0); } while (0)
#define PG8_WAIT_V(n) asm volatile("s_waitcnt vmcnt(" #n ")" ::: "memory")
#define PG8_WAIT_L(n) asm volatile("s_waitcnt lgkmcnt(" #n ")" ::: "memory")
#define PG8_BAR __builtin_amdgcn_s_barrier()
#define PG8_SCHED __builtin_amdgcn_sched_barrier(0)
    Unit cur, nxt; int ui = 0;
    if (!S.next(0, cur)) return;
    f32x4 acc[2][2][4][2];
#pragma unroll
    for (int a = 0; a < 2; ++a)
#pragma unroll
        for (int b = 0; b < 2; ++b)
#pragma unroll
            for (int m = 0; m < 4; ++m)
#pragma unroll
                for (int n = 0; n < 2; ++n) acc[a][b][m][n] = (f32x4){0.f, 0.f, 0.f, 0.f};
    bf16x8 At[4][2], B0[2][2], B1[2][2];
    const char* cA = (const char*)g.A + (size_t)cur.pm * tstep; const char* cB = (const char*)g.Bt + (size_t)cur.pn * tstep;
    S.a_ready(cur);
    if constexpr (SP2) {
        PG8_STAGE(PG8_SB(0, 0), cB, voffB); PG8_STAGE(PG8_SB(0, 1), cB + hstep, voffB); PG8_STAGE(PG8_SA(0, 0), cA, voffA); PG8_STAGE(PG8_SA(0, 1), cA + hstep, voffA);
        if (wr == 1) PG8_BAR;
        PG8_WAIT_V(2); PG8_BAR;
        PG8_STAGE(PG8_SB(1, 0), cB + kstep, voffB); PG8_STAGE(PG8_SA(1, 0), cA + kstep, voffA); PG8_STAGE(PG8_SB(1, 1), cB + hstep + kstep, voffB);
        PG8_WAIT_V(6); PG8_BAR;
    } else {
        PG8_STAGE(PG8_SB(0, 0), cB, voffB); PG8_STAGE(PG8_SA(0, 0), cA, voffA); PG8_STAGE(PG8_SB(0, 1), cB + hstep, voffB); PG8_STAGE(PG8_SA(0, 1), cA + hstep, voffA);
        if (wr == 1) PG8_BAR;
        PG8_WAIT_V(4); PG8_BAR;
        PG8_STAGE(PG8_SB(1, 0), cB + kstep, voffB); PG8_STAGE(PG8_SA(1, 0), cA + kstep, voffA); PG8_STAGE(PG8_SB(1, 1), cB + hstep + kstep, voffB);
        PG8_WAIT_V(6); PG8_BAR;
    }
    for (;;) {
        const bool has_next = S.next(ui + 1, nxt);
        const char* nA = has_next ? (const char*)g.A + (size_t)nxt.pm * tstep : cA; const char* nB = has_next ? (const char*)g.Bt + (size_t)nxt.pn * tstep : cB;
        for (int t = 0; t < nt; t += 2) {
            const bool last = (t == nt - 2);
            const char* a1 = cA + (size_t)(t + 1) * kstep;
            const char* a2 = last ? nA : cA + (size_t)(t + 2) * kstep; const char* b2 = last ? nB : cB + (size_t)(t + 2) * kstep;
            const char* a3 = a2 + kstep; const char* b3 = b2 + kstep;
            if (last && has_next) S.a_ready(nxt);
            if constexpr (SP2) {
            PG8_LDB(B0, 0, 0); PG8_LDB(B1, 0, 1); PG8_SCHED; PG8_LDA(At, 0, 0); PG8_STAGE(PG8_SA(1, 1), a1 + hstep, voffA);
            PG8_WAIT_V(8); PG8_WAIT_L(0); PG8_BAR; PG8_MMA(0, 0, At, B0); PG8_MMA(0, 1, At, B1); PG8_BAR; PG8_SCHED;
            PG8_LDA(At, 0, 1); PG8_STAGE(PG8_SB(0, 0), b2, voffB); PG8_STAGE(PG8_SB(0, 1), b2 + hstep, voffB); PG8_STAGE(PG8_SA(0, 0), a2, voffA);
            PG8_WAIT_V(8); PG8_WAIT_L(0); PG8_BAR; PG8_MMA(1, 0, At, B0); PG8_MMA(1, 1, At, B1); PG8_BAR; PG8_SCHED;
            PG8_LDB(B0, 1, 0); PG8_LDB(B1, 1, 1); PG8_SCHED; PG8_LDA(At, 1, 0); PG8_STAGE(PG8_SA(0, 1), a2 + hstep, voffA);
            PG8_WAIT_V(8); PG8_WAIT_L(0); PG8_BAR; PG8_MMA(0, 0, At, B0); PG8_MMA(0, 1, At, B1); PG8_BAR; PG8_SCHED;
            PG8_LDA(At, 1, 1); PG8_STAGE(PG8_SB(1, 0), b3, voffB); PG8_STAGE(PG8_SB(1, 1), b3 + hstep, voffB); PG8_STAGE(PG8_SA(1, 0), a3, voffA);
            PG8_WAIT_V(8); PG8_WAIT_L(0); PG8_BAR; PG8_MMA(1, 0, At, B0); PG8_MMA(1, 1, At, B1); PG8_BAR; PG8_SCHED;
            } else {
            PG8_LDB(B0, 0, 0); PG8_SCHED; PG8_LDA(At, 0, 0); PG8_STAGE(PG8_SA(1, 1), a1 + hstep, voffA);
            PG8_WAIT_L(8); PG8_BAR; PG8_WAIT_L(0); PG8_MMA(0, 0, At, B0); PG8_BAR; PG8_SCHED;
            PG8_LDB(B1, 0, 1); PG8_STAGE(PG8_SB(0, 0), b2, voffB);
            PG8_BAR; PG8_WAIT_L(0); PG8_MMA(0, 1, At, B1); PG8_BAR;
            PG8_LDA(At, 0, 1); PG8_STAGE(PG8_SA(0, 0), a2, voffA);
            PG8_BAR; PG8_WAIT_L(0); PG8_MMA(1, 0, At, B0); PG8_BAR; PG8_SCHED;
            PG8_STAGE(PG8_SB(0, 1), b2 + hstep, voffB);
            PG8_WAIT_V(6); PG8_BAR; PG8_MMA(1, 1, At, B1); PG8_BAR;
            PG8_LDB(B0, 1, 0); PG8_SCHED; PG8_LDA(At, 1, 0); PG8_STAGE(PG8_SA(0, 1), a2 + hstep, voffA);
            PG8_WAIT_L(8); PG8_BAR; PG8_WAIT_L(0); PG8_MMA(0, 0, At, B0); PG8_BAR; PG8_SCHED;
            PG8_LDB(B1, 1, 1); PG8_STAGE(PG8_SB(1, 0), b3, voffB);
            PG8_BAR; PG8_WAIT_L(0); PG8_MMA(0, 1, At, B1); PG8_BAR;
            PG8_LDA(At, 1, 1); PG8_STAGE(PG8_SA(1, 0), a3, voffA);
            PG8_BAR; PG8_WAIT_L(0); PG8_MMA(1, 0, At, B0); PG8_BAR; PG8_SCHED;
            PG8_STAGE(PG8_SB(1, 1), b3 + hstep, voffB);
            PG8_WAIT_V(6); PG8_BAR; PG8_MMA(1, 1, At, B1); PG8_BAR;
            }
        }
        if constexpr (ALIGN_EPI) { if (wr == 0) PG8_BAR; }
        if constexpr (!Epi::AFTER_DRAIN) { E(acc, cur, wr, wc, fr, fq); S.done(cur); }
        if (!has_next) break;
#pragma unroll
        for (int a = 0; a < 2; ++a)
#pragma unroll
            for (int b = 0; b < 2; ++b)
#pragma unroll
                for (int m = 0; m < 4; ++m)
#pragma unroll
                    for (int n = 0; n < 2; ++n) acc[a][b][m][n] = (f32x4){0.f, 0.f, 0.f, 0.f};
        cur = nxt; cA = nA; cB = nB; ++ui;
        if constexpr (ALIGN_EPI) { if (wr == 1) PG8_BAR; }
    }
    PG8_WAIT_V(0);
    if constexpr (!ALIGN_EPI) { if (wr == 0) PG8_BAR; }
    PG8_BAR;
    if constexpr (Epi::AFTER_DRAIN) { E.fused(acc, cur, wr, wc, fr, fq, lds, wid, lane); S.done(cur); }
#undef PG8_SA
#undef PG8_SB
#undef PG8_STAGE
#undef PG8_LDA
#undef PG8_LDB
#undef PG8_MMA
#undef PG8_WAIT_V
#undef PG8_WAIT_L
#undef PG8_BAR
#undef PG8_SCHED
}
}

#ifndef MK_N_LAUNCHES
#define MK_N_LAUNCHES 1
#endif
constexpr int DM = 1024, NPROMPT = 16384, M = 17408, SEQ = 2048;
constexpr int NIN = 3584, PROJW = 3072, FF = 2816, NGU = 5632;
constexpr int NPHASE = 9;
constexpr int NWAVES = 8;
constexpr size_t MiB = 1u << 20;
constexpr size_t WS_WIN = 0, WS_WOUT = 7 * MiB, WS_WGU = 9 * MiB, WS_WDN = 20 * MiB, WS_CS = 26 * MiB, WS_SS2 = 28 * MiB;
constexpr size_t WS_XN = 30 * MiB;
constexpr size_t WS_PROJ = 64 * MiB;
constexpr size_t WS_KV = 166 * MiB;
constexpr size_t WS_RS = 198 * MiB;
constexpr size_t WS_MIX = 214 * MiB;
constexpr size_t WS_END = 248 * MiB;
constexpr int LDS_BYTES = 147456, MISC_OFF = 143360;
constexpr size_t WS_CTL = 29 * MiB + 512 * 1024, CTL_BYTES = 16384;
constexpr size_t OUT_Y = 0, OUT_NCP = (size_t)M * DM, OUT_NRP = OUT_NCP + 8192, OUT_NCS = OUT_NRP + 524288, OUT_NRS = OUT_NCS + 131072;

#define GAS __attribute__((address_space(1)))
#define LAS __attribute__((address_space(3)))
typedef unsigned short bf16;
typedef unsigned v4u __attribute__((ext_vector_type(4)));
typedef unsigned v2u __attribute__((ext_vector_type(2)));
typedef float f32x4 __attribute__((ext_vector_type(4)));
typedef short bf16x8 __attribute__((ext_vector_type(8)));
typedef short s16x4 __attribute__((ext_vector_type(4)));
using pg8::cvt_pk_bf16;
#define LDS_WAIT() asm volatile("s_waitcnt lgkmcnt(0)" ::: "memory")

__device__ __forceinline__ float bf2f(unsigned h) { return __builtin_bit_cast(float, h << 16); }
__device__ __forceinline__ float bflo(unsigned w) { return __builtin_bit_cast(float, w << 16); }
__device__ __forceinline__ float bfhi(unsigned w) { return __builtin_bit_cast(float, w & 0xffff0000u); }
__device__ __forceinline__ v4u pack8(f32x4 a, f32x4 b) { v4u w; w.x = cvt_pk_bf16(a[0], a[1]); w.y = cvt_pk_bf16(a[2], a[3]); w.z = cvt_pk_bf16(b[0], b[1]); w.w = cvt_pk_bf16(b[2], b[3]); return w; }
__device__ __forceinline__ void unpack8(v4u w, f32x4& a, f32x4& b) { a = (f32x4){bflo(w.x), bfhi(w.x), bflo(w.y), bfhi(w.y)}; b = (f32x4){bflo(w.z), bfhi(w.z), bflo(w.w), bfhi(w.w)}; }
__device__ __forceinline__ float wave_sum(float v) {
#pragma unroll
    for (int o = 1; o < 64; o <<= 1) v += __shfl_xor(v, o);
    return v;
}
__device__ __forceinline__ float silu_f(float x) { return x * __builtin_amdgcn_rcpf(1.0f + __builtin_amdgcn_exp2f(-1.4426950408889634f * x)); }
__device__ __forceinline__ float log2_gamma(int h) { return log2f(1.0f - exp2f(-5.0f - (float)h)); }

struct EpiInProj {
    static constexpr bool PERM = true, AFTER_DRAIN = false;
    bf16* P; const float* cs;
    __device__ __forceinline__ void operator()(const f32x4 (&acc)[2][2][4][2], const pg8::Unit& u, int wr, int wc, int fr, int fq) const {
        const int pn = u.pn, cgp = wc * 32 + 8 * fq, rowb = u.pm * 256 + wr * 64 + fr;
        if (pn < 4) {
            const int sec = pn >> 1, head = 2 * (pn & 1) + (cgp >> 6), dd = cgp & 63;
            const float sc = sec ? 0.08838834764831845f : 1.0f;
            const int oc = sec * 512 + head * 128 + dd;
#pragma unroll
            for (int ai = 0; ai < 2; ++ai)
#pragma unroll
                for (int m = 0; m < 4; ++m) {
                    const int row = rowb + ai * 128 + m * 16;
                    const int pidx = row < NPROMPT ? (row & (SEQ - 1)) : SEQ + (row & 7);
                    const float* t = cs + (size_t)pidx * 128 + dd;
                    const f32x4 c0 = *(const f32x4*)t, c1 = *(const f32x4*)(t + 4), s0 = *(const f32x4*)(t + 64), s1 = *(const f32x4*)(t + 68);
                    const f32x4 a0 = acc[ai][0][m][0], a1 = acc[ai][0][m][1], b0 = acc[ai][1][m][0], b1 = acc[ai][1][m][1];
                    bf16* o = P + (size_t)row * PROJW + oc;
                    *(v4u*)o = pack8((a0 * c0 - b0 * s0) * sc, (a1 * c1 - b1 * s1) * sc);
                    *(v4u*)(o + 64) = pack8((a0 * s0 + b0 * c0) * sc, (a1 * s1 + b1 * c1) * sc);
                }
        } else if (pn < 10) {
#pragma unroll
            for (int ai = 0; ai < 2; ++ai)
#pragma unroll
                for (int m = 0; m < 4; ++m) {
                    const int row = rowb + ai * 128 + m * 16;
                    bf16* o = P + (size_t)row * PROJW + pn * 256 + cgp;
                    *(v4u*)o = pack8(acc[ai][0][m][0], acc[ai][0][m][1]);
                    *(v4u*)(o + 128) = pack8(acc[ai][1][m][0], acc[ai][1][m][1]);
                }
        } else {
#pragma unroll
            for (int ai = 0; ai < 2; ++ai)
#pragma unroll
                for (int m = 0; m < 4; ++m) {
                    const int row = rowb + ai * 128 + m * 16;
                    bf16* o = P + (size_t)row * PROJW + 2560 + (pn - 10) * 128 + cgp;
                    *(v4u*)o = pack8(acc[ai][0][m][0] * acc[ai][1][m][0], acc[ai][0][m][1] * acc[ai][1][m][1]);
                }
        }
    }
};
struct EpiOut {
    static constexpr bool PERM = true, AFTER_DRAIN = false;
    const float* xp; const float* xs; float* x1; bf16* h2; const float* g2; float* ss2;
    __device__ __forceinline__ void operator()(const f32x4 (&acc)[2][2][4][2], const pg8::Unit& u, int wr, int wc, int fr, int fq) const {
        const int cgp = wc * 32 + 8 * fq, rowb = u.pm * 256 + wr * 64 + fr;
#pragma unroll
        for (int ai = 0; ai < 2; ++ai)
#pragma unroll
            for (int m = 0; m < 4; ++m) {
                const int row = rowb + ai * 128 + m * 16;
                const float* xr = row < NPROMPT ? xp + (size_t)row * DM : xs + (size_t)(row - NPROMPT) * DM;
                float ss = 0.f;
#pragma unroll
                for (int bj = 0; bj < 2; ++bj) {
                    const int col = u.pn * 256 + bj * 128 + cgp;
                    const f32x4 v0 = acc[ai][bj][m][0] + *(const f32x4*)(xr + col), v1 = acc[ai][bj][m][1] + *(const f32x4*)(xr + col + 4);
                    float* o = x1 + (size_t)row * DM + col;
                    *(f32x4*)o = v0; *(f32x4*)(o + 4) = v1;
                    ss += (v0[0] * v0[0] + v0[1] * v0[1]) + (v0[2] * v0[2] + v0[3] * v0[3]) + (v1[0] * v1[0] + v1[1] * v1[1]) + (v1[2] * v1[2] + v1[3] * v1[3]);
                    const f32x4 g0 = *(const f32x4*)(g2 + col), g1 = *(const f32x4*)(g2 + col + 4);
                    *(v4u*)(h2 + (size_t)row * DM + col) = pack8(v0 * g0, v1 * g1);
                }
                ss += __shfl_xor(ss, 16); ss += __shfl_xor(ss, 32);
                if (fq == 0) ss2[(size_t)row * 16 + u.pn * 4 + wc] = ss;
            }
    }
};
struct EpiGU {
    static constexpr bool PERM = true, AFTER_DRAIN = false;
    const float* ss2; bf16* act;
    __device__ __forceinline__ void operator()(const f32x4 (&acc)[2][2][4][2], const pg8::Unit& u, int wr, int wc, int fr, int fq) const {
        const int cgp = wc * 32 + 8 * fq, rowb = u.pm * 256 + wr * 64 + fr;
#pragma unroll
        for (int ai = 0; ai < 2; ++ai)
#pragma unroll
            for (int m = 0; m < 4; ++m) {
                const int row = rowb + ai * 128 + m * 16;
                const f32x4* sp = (const f32x4*)(ss2 + (size_t)row * 16);
                const f32x4 p0 = sp[0], p1 = sp[1], p2 = sp[2], p3 = sp[3];
                const f32x4 ps = (p0 + p1) + (p2 + p3);
                const float r = rsqrtf(((ps[0] + ps[1]) + (ps[2] + ps[3])) * (1.0f / DM) + 1e-6f);
                f32x4 o[2];
#pragma unroll
                for (int n = 0; n < 2; ++n) {
                    const f32x4 g = acc[ai][0][m][n] * r, up = acc[ai][1][m][n] * r;
                    o[n] = (f32x4){silu_f(g[0]) * up[0], silu_f(g[1]) * up[1], silu_f(g[2]) * up[2], silu_f(g[3]) * up[3]};
                }
                *(v4u*)(act + (size_t)row * FF + u.pn * 128 + cgp) = pack8(o[0], o[1]);
            }
    }
};
struct EpiDown {
    static constexpr bool PERM = true, AFTER_DRAIN = false;
    float* io;
    __device__ __forceinline__ void operator()(const f32x4 (&acc)[2][2][4][2], const pg8::Unit& u, int wr, int wc, int fr, int fq) const {
        const int cgp = wc * 32 + 8 * fq, rowb = u.pm * 256 + wr * 64 + fr;
#pragma unroll
        for (int ai = 0; ai < 2; ++ai)
#pragma unroll
            for (int m = 0; m < 4; ++m) {
                const int row = rowb + ai * 128 + m * 16;
#pragma unroll
                for (int bj = 0; bj < 2; ++bj) {
                    float* o = io + (size_t)row * DM + u.pn * 256 + bj * 128 + cgp;
                    const f32x4 v0 = acc[ai][bj][m][0] + *(const f32x4*)o, v1 = acc[ai][bj][m][1] + *(const f32x4*)(o + 4);
                    *(f32x4*)o = v0; *(f32x4*)(o + 4) = v1;
                }
            }
    }
};

__device__ __forceinline__ unsigned off_b(unsigned row, unsigned ch) { return 256u * row + 16u * (ch ^ (((row & 3u) << 2) | ((row >> 2) & 3u))); }
__device__ __forceinline__ unsigned row_addr16(unsigned lane, unsigned rb, unsigned s) { return off_b((lane & 15u) + 16u * rb, 4u * s + (lane >> 4)); }
__device__ __forceinline__ unsigned tr_addr16(unsigned lane, unsigned c, unsigned ks, unsigned t) {
    const unsigned g = lane >> 4, q = (lane & 15u) >> 2, p = lane & 3u;
    return off_b(32u * ks + 8u * g + 4u * t + q, 2u * c + (p >> 1)) + 8u * (p & 1u);
}
__device__ __forceinline__ void tr_frags4(unsigned img, unsigned lane, unsigned c, bf16x8 (&f)[4]) {
    const unsigned a0 = img + tr_addr16(lane, c, 0, 0), a1 = img + tr_addr16(lane, c, 0, 1);
    s16x4 r0, r1, r2, r3, r4, r5, r6, r7;
    asm volatile("ds_read_b64_tr_b16 %0, %8\n\t"
                 "ds_read_b64_tr_b16 %1, %9\n\t"
                 "ds_read_b64_tr_b16 %2, %8 offset:8192\n\t"
                 "ds_read_b64_tr_b16 %3, %9 offset:8192\n\t"
                 "ds_read_b64_tr_b16 %4, %8 offset:16384\n\t"
                 "ds_read_b64_tr_b16 %5, %9 offset:16384\n\t"
                 "ds_read_b64_tr_b16 %6, %8 offset:24576\n\t"
                 "ds_read_b64_tr_b16 %7, %9 offset:24576\n\t"
                 "s_waitcnt lgkmcnt(0)"
                 : "=&v"(r0), "=&v"(r1), "=&v"(r2), "=&v"(r3), "=&v"(r4), "=&v"(r5), "=&v"(r6), "=&v"(r7)
                 : "v"(a0), "v"(a1) : "memory");
    f[0] = (bf16x8){r0[0], r0[1], r0[2], r0[3], r1[0], r1[1], r1[2], r1[3]};
    f[1] = (bf16x8){r2[0], r2[1], r2[2], r2[3], r3[0], r3[1], r3[2], r3[3]};
    f[2] = (bf16x8){r4[0], r4[1], r4[2], r4[3], r5[0], r5[1], r5[2], r5[3]};
    f[3] = (bf16x8){r6[0], r6[1], r6[2], r6[3], r7[0], r7[1], r7[2], r7[3]};
}
#define MFMA16(a, b, c) __builtin_amdgcn_mfma_f32_16x16x32_bf16((a), (b), (c), 0, 0, 0)

template <bool SCALE>
__device__ __forceinline__ void stage_tile(LAS unsigned char* img, const bf16* src, size_t pitch, int tid, float zl) {
    v4u v[4];
#pragma unroll
    for (int k = 0; k < 4; ++k) { const int id = tid + 512 * k, row = id >> 4, ch = id & 15; v[k] = *(const v4u*)(src + (size_t)row * pitch + ch * 8); }
#pragma unroll
    for (int k = 0; k < 4; ++k) { const int id = tid + 512 * k, row = id >> 4, ch = id & 15;
        v4u w = v[k];
        if (SCALE) { f32x4 a, b; unpack8(w, a, b); const float z = __builtin_amdgcn_exp2f((float)(127 - row) * zl); w = pack8(a * z, b * z); }
        *(LAS v4u*)(img + off_b(row, ch)) = w; }
}

__device__ __forceinline__ void kv_unit(LAS unsigned char* lds, const bf16* proj, float* kv, int unit, int tid) {
    const int b = unit >> 6, h = (unit >> 4) & 3, c = unit & 15, row0 = b * SEQ + c * 128;
    const int lane = tid & 63, w = __builtin_amdgcn_readfirstlane(tid >> 6), fr = lane & 15, fq = lane >> 4;
    const float l2g = log2_gamma(h);
    LAS unsigned char* Kimg = lds; LAS unsigned char* Vimg = lds + 32768;
    stage_tile<true>(Kimg, proj + (size_t)row0 * PROJW + 512 + h * 128, PROJW, tid, l2g);
    stage_tile<false>(Vimg, proj + (size_t)row0 * PROJW + 1024 + h * 128, PROJW, tid, 0.f);
    __syncthreads();
    bf16x8 aK[4]; tr_frags4((unsigned)(size_t)Kimg, lane, w, aK);
    float* o = kv + (size_t)unit * 16384 + (size_t)(16 * w + 4 * fq) * 128 + fr;
#pragma unroll
    for (int nb = 0; nb < 8; ++nb) {
        bf16x8 bV[4]; tr_frags4((unsigned)(size_t)Vimg, lane, nb, bV);
        f32x4 acc = {0.f, 0.f, 0.f, 0.f};
#pragma unroll
        for (int s = 0; s < 4; ++s) acc = MFMA16(aK[s], bV[s], acc);
#pragma unroll
        for (int e = 0; e < 4; ++e) o[e * 128 + nb * 16] = acc[e];
    }
    __syncthreads();
}

__device__ __forceinline__ void sample_unit(LAS unsigned char* lds, const bf16* proj, const float* state_ret, const float* gn_g, bf16* mix, float* new_ret, int unit, int tid) {
    const int b = unit >> 2, h = unit & 3, row0 = NPROMPT + b * 8;
    const int lane = tid & 63, w = __builtin_amdgcn_readfirstlane(tid >> 6);
    LAS float* qT = (LAS float*)lds;
    LAS float* kzT = qT + 1024;
    LAS float* kT = kzT + 1024;
    LAS float* vs = kT + 1024;
    LAS float* sc = vs + 1024;
    LAS float* po = sc + 64;
    const float l2g = log2_gamma(h);
#pragma unroll
    for (int k2 = 0; k2 < 2; ++k2) {
        const int e = tid + 512 * k2, i = e >> 7, d = e & 127;
        const bf16* base = proj + (size_t)(row0 + i) * PROJW + h * 128 + d;
        const float q = bf2f(base[0]), k = bf2f(base[512]), v = bf2f(base[1024]);
        qT[d * 8 + i] = q; kT[d * 8 + i] = k; kzT[d * 8 + i] = k * __builtin_amdgcn_exp2f((float)(7 - i) * l2g); vs[i * 128 + d] = v;
    }
    __syncthreads();
    if (tid < 64) {
        const int i = tid >> 3, j = tid & 7; float s = 0.f;
        for (int d = 0; d < 128; ++d) s += qT[d * 8 + i] * kT[d * 8 + j];
        sc[i * 8 + j] = (j <= i) ? s * __builtin_amdgcn_exp2f((float)(i - j) * l2g) : 0.f;
    }
    const int v4 = (tid & 31) * 4, dg = tid >> 5;
    f32x4 vv[8], pacc[8];
#pragma unroll
    for (int j = 0; j < 8; ++j) { vv[j] = *(const LAS f32x4*)(vs + j * 128 + v4); pacc[j] = (f32x4){0.f, 0.f, 0.f, 0.f}; }
    const float g8 = __builtin_amdgcn_exp2f(8.0f * l2g);
    const float* Rin = state_ret + (size_t)(b * 4 + h) * 16384 + v4;
    float* Rout = new_ret + (size_t)(b * 4 + h) * 16384 + v4;
    f32x4 rr[8];
#pragma unroll
    for (int dd = 0; dd < 8; ++dd) rr[dd] = *(const f32x4*)(Rin + (size_t)(dg * 8 + dd) * 128);
#pragma unroll
    for (int dd = 0; dd < 8; ++dd) {
        const int d = dg * 8 + dd; const f32x4 r = rr[dd];
        const f32x4 q0 = *(const LAS f32x4*)(qT + d * 8), q1 = *(const LAS f32x4*)(qT + d * 8 + 4);
        const f32x4 z0 = *(const LAS f32x4*)(kzT + d * 8), z1 = *(const LAS f32x4*)(kzT + d * 8 + 4);
        f32x4 rn = r * g8;
#pragma unroll
        for (int i = 0; i < 4; ++i) { pacc[i] += r * q0[i]; pacc[4 + i] += r * q1[i]; rn += vv[i] * z0[i]; rn += vv[4 + i] * z1[i]; }
        *(f32x4*)(Rout + (size_t)d * 128) = rn;
    }
#pragma unroll
    for (int i = 0; i < 8; ++i) {
#pragma unroll
        for (int k = 0; k < 4; ++k) pacc[i][k] += __shfl_xor(pacc[i][k], 32);
        if (lane < 32) *(LAS f32x4*)(po + (w * 8 + i) * 128 + v4) = pacc[i];
    }
    __syncthreads();
    {
        const int i = w, v = lane * 2;
        float o0 = 0.f, o1 = 0.f;
#pragma unroll
        for (int ww = 0; ww < 8; ++ww) { o0 += po[(ww * 8 + i) * 128 + v]; o1 += po[(ww * 8 + i) * 128 + v + 1]; }
        const float xi = __builtin_amdgcn_exp2f((float)(i + 1) * l2g);
        o0 *= xi; o1 *= xi;
#pragma unroll
        for (int j = 0; j < 8; ++j) { const float s = sc[i * 8 + j]; o0 += s * vs[j * 128 + v]; o1 += s * vs[j * 128 + v + 1]; }
        const float mean = wave_sum(o0 + o1) * (1.0f / 128.0f);
        const float d0 = o0 - mean, d1 = o1 - mean;
        const float var = wave_sum(d0 * d0 + d1 * d1) * (1.0f / 128.0f);
        const float rstd = rsqrtf(var + 1e-5f);
        const unsigned gw = *(const unsigned*)(proj + (size_t)(row0 + i) * PROJW + 1536 + h * 128 + v);
        const float y0 = silu_f(bflo(gw)) * (d0 * rstd * gn_g[h * 128 + v]), y1 = silu_f(bfhi(gw)) * (d1 * rstd * gn_g[h * 128 + v + 1]);
        *(unsigned*)(mix + (size_t)(row0 + i) * DM + h * 128 + v) = cvt_pk_bf16(y0, y1);
    }
    __syncthreads();
}

__device__ __forceinline__ void conv_unit(const bf16* proj, const float* state_conv, const float* conv_w, bf16* mix, float* ncp, float* ncs, int unit, int tid) {
    const int cgp = (tid & 63) * 8, w = tid >> 6;
    const f32x4 w0a = *(const f32x4*)(conv_w + cgp), w0b = *(const f32x4*)(conv_w + cgp + 4);
    const f32x4 w1a = *(const f32x4*)(conv_w + 512 + cgp), w1b = *(const f32x4*)(conv_w + 512 + cgp + 4);
    const f32x4 w2a = *(const f32x4*)(conv_w + 1024 + cgp), w2b = *(const f32x4*)(conv_w + 1024 + cgp + 4);
#pragma unroll
    for (int rr = 0; rr < 4; ++rr) {
        const int m = unit * 32 + w + 8 * rr;
        const bool samp = m >= NPROMPT;
        const int l = samp ? (m & 7) : (m & (SEQ - 1)), bb = samp ? ((m - NPROMPT) >> 3) : (m >> 11);
        const bf16* pr = proj + (size_t)m * PROJW + cgp;
        f32x4 u2a, u2b, ga, gb, u1a, u1b, u0a, u0b;
        unpack8(*(const v4u*)(pr + 2560), u2a, u2b);
        unpack8(*(const v4u*)(pr + 2048), ga, gb);
        const f32x4 zero = {0.f, 0.f, 0.f, 0.f};
        if (l >= 1) unpack8(*(const v4u*)(pr + 2560 - PROJW), u1a, u1b);
        else if (samp) { const float* s = state_conv + (size_t)(bb * 2 + 1) * 512 + cgp; u1a = *(const f32x4*)s; u1b = *(const f32x4*)(s + 4); }
        else { u1a = zero; u1b = zero; }
        if (l >= 2) unpack8(*(const v4u*)(pr + 2560 - 2 * PROJW), u0a, u0b);
        else if (samp) { const float* s = state_conv + (size_t)(bb * 2 + l) * 512 + cgp; u0a = *(const f32x4*)s; u0b = *(const f32x4*)(s + 4); }
        else { u0a = zero; u0b = zero; }
        const f32x4 ya = w0a * u0a + w1a * u1a + w2a * u2a, yb = w0b * u0b + w1b * u1b + w2b * u2b;
        *(v4u*)(mix + (size_t)m * DM + 512 + cgp) = pack8(ga * ya, gb * yb);
        const int L = samp ? 8 : SEQ;
        if (l >= L - 2) { float* d = (samp ? ncs : ncp) + (size_t)(bb * 2 + (l - (L - 2))) * 512 + cgp; *(f32x4*)d = u2a; *(f32x4*)(d + 4) = u2b; }
    }
}

__device__ __forceinline__ unsigned tr_addr16p(unsigned lane, unsigned c, unsigned t) {
    const unsigned g = lane >> 4, q = (lane & 15u) >> 2, p = lane & 3u;
    return off_b(16u * t + 4u * g + q, 2u * c + (p >> 1)) + 8u * (p & 1u);
}
__device__ __forceinline__ void tr_frags4p(unsigned img, unsigned lane, unsigned c, bf16x8 (&f)[4]) {
    const unsigned a0 = img + tr_addr16p(lane, c, 0), a1 = img + tr_addr16p(lane, c, 1);
    s16x4 r0, r1, r2, r3, r4, r5, r6, r7;
    asm volatile("ds_read_b64_tr_b16 %0, %8\n\t"
                 "ds_read_b64_tr_b16 %1, %9\n\t"
                 "ds_read_b64_tr_b16 %2, %8 offset:8192\n\t"
                 "ds_read_b64_tr_b16 %3, %9 offset:8192\n\t"
                 "ds_read_b64_tr_b16 %4, %8 offset:16384\n\t"
                 "ds_read_b64_tr_b16 %5, %9 offset:16384\n\t"
                 "ds_read_b64_tr_b16 %6, %8 offset:24576\n\t"
                 "ds_read_b64_tr_b16 %7, %9 offset:24576\n\t"
                 "s_waitcnt lgkmcnt(0)"
                 : "=&v"(r0), "=&v"(r1), "=&v"(r2), "=&v"(r3), "=&v"(r4), "=&v"(r5), "=&v"(r6), "=&v"(r7)
                 : "v"(a0), "v"(a1) : "memory");
    f[0] = (bf16x8){r0[0], r0[1], r0[2], r0[3], r1[0], r1[1], r1[2], r1[3]};
    f[1] = (bf16x8){r2[0], r2[1], r2[2], r2[3], r3[0], r3[1], r3[2], r3[3]};
    f[2] = (bf16x8){r4[0], r4[1], r4[2], r4[3], r5[0], r5[1], r5[2], r5[3]};
    f[3] = (bf16x8){r6[0], r6[1], r6[2], r6[3], r7[0], r7[1], r7[2], r7[3]};
}
__device__ __forceinline__ void ro_phase(LAS unsigned char* lds, const bf16* proj, const bf16* rs, const float* gn_g, bf16* mix, int bx, int G, int tid) {
    const int lane = tid & 63, w = __builtin_amdgcn_readfirstlane(tid >> 6), fr = lane & 15, fq = lane >> 4;
    LAS unsigned char* Kimg = lds; LAS unsigned char* Vimg = lds + 32768; LAS unsigned char* Rimg = lds + 65536; LAS unsigned char* Stg = lds + 98304 + w * 4096;
    v4u pk[4], pv[4], pr[4]; bf16x8 pq[4];
#define RO_LOAD(unit) do { const int b_ = (unit) >> 6, h_ = ((unit) >> 4) & 3, c_ = (unit) & 15, row0_ = b_ * SEQ + c_ * 128; const bf16* pb_ = proj + (size_t)row0_ * PROJW + h_ * 128; \
        _Pragma("unroll") for (int k = 0; k < 4; ++k) { const int id = tid + 512 * k, row = id >> 4, ch = id & 15; const bf16* p_ = pb_ + (size_t)row * PROJW + ch * 8; \
            pk[k] = *(const v4u*)(p_ + 512); pv[k] = *(const v4u*)(p_ + 1024); pr[k] = *(const v4u*)(rs + (size_t)(unit) * 16384 + row * 128 + ch * 8); } \
        _Pragma("unroll") for (int s = 0; s < 4; ++s) pq[s] = *(const bf16x8*)(pb_ + (size_t)(16 * w + fr) * PROJW + 32 * s + 8 * fq); } while (0)
    int it = bx;
    if (it < 512) RO_LOAD(it);
    const int tid_o = tid, lane_o = lane;
    for (; it < 512; it += G) {
        int tid = tid_o, lane = lane_o;
        asm volatile("" : "+v"(tid), "+v"(lane));
        const int fr = lane & 15, fq = lane >> 4;
        const int b = it >> 6, h = (it >> 4) & 3, c = it & 15, row0 = b * SEQ + c * 128;
        const float l2g = log2_gamma(h);
#pragma unroll
        for (int k = 0; k < 4; ++k) { const int id = tid + 512 * k, row = id >> 4, ch = id & 15; const unsigned o = off_b(row, ch);
            *(LAS v4u*)(Kimg + o) = pk[k]; *(LAS v4u*)(Vimg + o) = pv[k]; *(LAS v4u*)(Rimg + o) = pr[k]; }
        bf16x8 aQ[4]; v4u gv[4];
#pragma unroll
        for (int s = 0; s < 4; ++s) aQ[s] = pq[s];
#pragma unroll
        for (int k = 0; k < 4; ++k) { const int id = lane + 64 * k, r = id >> 4, ch = id & 15; gv[k] = *(const v4u*)(proj + (size_t)(row0 + 16 * w + r) * PROJW + 1536 + h * 128 + ch * 8); }
        float gg[8];
#pragma unroll
        for (int nb = 0; nb < 8; ++nb) gg[nb] = gn_g[h * 128 + nb * 16 + fr];
        __syncthreads();
        f32x4 accO[8];
        f32x4 xi4;
#pragma unroll
        for (int e = 0; e < 4; ++e) xi4[e] = __builtin_amdgcn_exp2f((float)(16 * w + 4 * fq + e + 1) * l2g);
#pragma unroll
        for (int nb = 0; nb < 8; ++nb) {
            bf16x8 bR[4]; tr_frags4((unsigned)(size_t)Rimg, lane, nb, bR);
            f32x4 a = {0.f, 0.f, 0.f, 0.f};
#pragma unroll
            for (int s = 0; s < 4; ++s) a = MFMA16(aQ[s], bR[s], a);
            accO[nb] = a * xi4;
        }
        const int il = 16 * w + fr;
        bf16x8 aP[4];
#pragma unroll
        for (int s = 0; s < 4; ++s) {
            v4u pw = {0u, 0u, 0u, 0u};
#pragma unroll
            for (int hf = 0; hf < 2; ++hf) {
                const int jb = 2 * s + hf;
                if (jb <= w) {
                    f32x4 a = {0.f, 0.f, 0.f, 0.f};
#pragma unroll
                    for (int s2 = 0; s2 < 4; ++s2) { const bf16x8 kf = *(const LAS bf16x8*)(Kimg + row_addr16(lane, jb, s2)); a = MFMA16(kf, aQ[s2], a); }
                    float p[4];
#pragma unroll
                    for (int e = 0; e < 4; ++e) { const int dlt = il - (16 * jb + 4 * fq + e); p[e] = dlt >= 0 ? a[e] * __builtin_amdgcn_exp2f((float)dlt * l2g) : 0.f; }
                    if (hf == 0) { pw.x = cvt_pk_bf16(p[0], p[1]); pw.y = cvt_pk_bf16(p[2], p[3]); } else { pw.z = cvt_pk_bf16(p[0], p[1]); pw.w = cvt_pk_bf16(p[2], p[3]); }
                }
            }
            aP[s] = __builtin_bit_cast(bf16x8, pw);
        }
        __builtin_amdgcn_sched_barrier(0);
        if (it + G < 512) RO_LOAD(it + G);
        __builtin_amdgcn_sched_barrier(0);
#pragma unroll
        for (int nb = 0; nb < 8; ++nb) {
            bf16x8 bV[4]; tr_frags4p((unsigned)(size_t)Vimg, lane, nb, bV);
            f32x4 a = accO[nb];
#pragma unroll
            for (int s = 0; s < 4; ++s) if (2 * s <= w) a = MFMA16(aP[s], bV[s], a);
            accO[nb] = a;
        }
#pragma unroll
        for (int e = 0; e < 4; ++e) {
            float o[8], sm = 0.f;
#pragma unroll
            for (int nb = 0; nb < 8; ++nb) { o[nb] = accO[nb][e]; sm += o[nb]; }
            sm += __shfl_xor(sm, 1); sm += __shfl_xor(sm, 2); sm += __shfl_xor(sm, 4); sm += __shfl_xor(sm, 8);
            const float mean = sm * (1.0f / 128.0f); float q = 0.f;
#pragma unroll
            for (int nb = 0; nb < 8; ++nb) { o[nb] -= mean; q += o[nb] * o[nb]; }
            q += __shfl_xor(q, 1); q += __shfl_xor(q, 2); q += __shfl_xor(q, 4); q += __shfl_xor(q, 8);
            const float rstd = rsqrtf(q * (1.0f / 128.0f) + 1e-5f);
            const unsigned ro = 4 * fq + e;
#pragma unroll
            for (int nb = 0; nb < 8; ++nb)
                *(LAS unsigned short*)(Stg + off_b(ro, 2 * nb + (fr >> 3)) + 2 * (fr & 7)) = (unsigned short)(cvt_pk_bf16(o[nb] * rstd * gg[nb], 0.f) & 0xffffu);
        }
#pragma unroll
        for (int k = 0; k < 4; ++k) {
            const int id = lane + 64 * k, r = id >> 4, ch = id & 15;
            const v4u ov = *(const LAS v4u*)(Stg + off_b(r, ch));
            f32x4 oa, ob, ga, gb; unpack8(ov, oa, ob); unpack8(gv[k], ga, gb);
            const f32x4 ya = {silu_f(ga[0]) * oa[0], silu_f(ga[1]) * oa[1], silu_f(ga[2]) * oa[2], silu_f(ga[3]) * oa[3]};
            const f32x4 yb = {silu_f(gb[0]) * ob[0], silu_f(gb[1]) * ob[1], silu_f(gb[2]) * ob[2], silu_f(gb[3]) * ob[3]};
            *(v4u*)(mix + (size_t)(row0 + 16 * w + r) * DM + h * 128 + ch * 8) = pack8(ya, yb);
        }
        __syncthreads();
    }
#undef RO_LOAD
}

#define RLX_AGENT __ATOMIC_RELAXED, __HIP_MEMORY_SCOPE_AGENT
#define XB_TMO      128
#define XB_XCNT(j)  (256  + 64 * (j))
#define XB_XSUB(j)  (1280 + 64 * (j))
#define XB_XGEN(j)  (2304 + 64 * (j))
#define XB_TOP      3328
#define XB_TOPGEN   3392
#define XCD_BAR_WORDS 3456
#define XB_SPIN_CAP (1u << 18)

__device__ __forceinline__ unsigned xb_ld(unsigned* p)              { return __hip_atomic_load(p, __ATOMIC_RELAXED, __HIP_MEMORY_SCOPE_AGENT); }
__device__ __forceinline__ unsigned xb_add(unsigned* p, unsigned v) { return __hip_atomic_fetch_add(p, v, __ATOMIC_RELAXED, __HIP_MEMORY_SCOPE_AGENT); }
__device__ __forceinline__ unsigned xb_xcc_id() { return (unsigned)__builtin_amdgcn_s_getreg((3 << 11) | 20) & 0xFu; }
#define XB_SPIN(cond, bar) do { unsigned _sp = 0; while (cond) { __builtin_amdgcn_s_sleep(1); \
    if ((++_sp & 255u) == 0u) { if (xb_ld(&(bar)[XB_TMO])) break; if (_sp > XB_SPIN_CAP) { atomicAdd(&(bar)[XB_TMO], 1u); break; } } } } while (0)

struct XcdBarrier {
    unsigned* bar; unsigned x;
    volatile LAS unsigned* st;
};

__device__ __forceinline__ XcdBarrier xcd_barrier_post(unsigned* bar, volatile LAS unsigned* st) {
    XcdBarrier b; b.bar = bar; b.x = xb_xcc_id(); b.st = st;
    if (threadIdx.x == 0) (void)xb_add(&bar[XB_XCNT(b.x)], 1u);
    return b;
}
__device__ __forceinline__ void xcd_barrier_complete(unsigned* bar, unsigned x, unsigned& nloc, unsigned& nx) {
    const unsigned G = gridDim.x * gridDim.y * gridDim.z;
    unsigned sum, cnt, mine, sp = 0u;
    for (;;) {
        sum = 0u; cnt = 0u; mine = 0u;
#pragma unroll
        for (unsigned j = 0; j < 16; ++j) { const unsigned c = xb_ld(&bar[XB_XCNT(j)]); sum += c; cnt += (c > 0u) ? 1u : 0u; mine = (j == x) ? c : mine; }
        if (sum == G) break;
        __builtin_amdgcn_s_sleep(1);
        if ((++sp & 255u) == 0u) { if (xb_ld(&bar[XB_TMO])) break; if (sp > XB_SPIN_CAP) { atomicAdd(&bar[XB_TMO], 1u); break; } }
    }
    nloc = mine > 0u ? mine : 1u; nx = cnt > 0u ? cnt : 1u;
}

__device__ __forceinline__ void xcd_barrier(const XcdBarrier& b) {
    asm volatile("s_waitcnt vmcnt(0)" ::: "memory");
    __syncthreads();
    if (threadIdx.x == 0) {
        unsigned* bar = b.bar;
        __builtin_amdgcn_s_waitcnt(0);
        unsigned nloc = b.st[0], nx = b.st[1];
        if (nloc == 0u) { xcd_barrier_complete(bar, b.x, nloc, nx); b.st[0] = nloc; b.st[1] = nx; }
        const unsigned old = xb_add(&bar[XB_XSUB(b.x)], 1u);
        const unsigned gen = old / nloc;
        if (old + 1u == (gen + 1u) * nloc) {
            __builtin_amdgcn_fence(__ATOMIC_RELEASE, "agent");
            asm volatile("s_waitcnt vmcnt(0)" ::: "memory");
            const unsigned og = xb_add(&bar[XB_TOP], 1u);
            const unsigned tg = og / nx;
            if (og + 1u == (tg + 1u) * nx) xb_add(&bar[XB_TOPGEN], 1u);
            else XB_SPIN(xb_ld(&bar[XB_TOPGEN]) == tg, bar);
            __builtin_amdgcn_fence(__ATOMIC_ACQUIRE, "agent");
            xb_add(&bar[XB_XGEN(b.x)], 1u);
            asm volatile("s_waitcnt vmcnt(0)" ::: "memory");
        } else {
            XB_SPIN(xb_ld(&bar[XB_XGEN(b.x)]) == gen, bar);
            __builtin_amdgcn_fence(__ATOMIC_ACQUIRE, "agent");
            asm volatile("s_waitcnt vmcnt(0)" ::: "memory");
        }
    }
    __syncthreads();
}

template <int MODE>
__device__ __forceinline__ void small_gemm_unit(LAS unsigned char* lds, const bf16* A, const bf16* Bt, const int K, const int row0, const int col0,
                                                const float* xs, float* io, bf16* h2, const float* g2, float* ss2, int tid) {
    const int lane = tid & 63, w = __builtin_amdgcn_readfirstlane(tid >> 6), fr = lane & 15, fq = lane >> 4;
    const int nks = K >> 5;
    f32x4 acc[2][8];
#pragma unroll
    for (int mb = 0; mb < 2; ++mb)
#pragma unroll
        for (int nb = 0; nb < 8; ++nb) acc[mb][nb] = (f32x4){0.f, 0.f, 0.f, 0.f};
    const bf16* ap = A + (size_t)(row0 + fr) * K + 8 * fq + 32 * w;
    const bf16* bp = Bt + (size_t)(col0 + fr) * K + 8 * fq + 32 * w;
    bf16x8 a[2], b[8];
#pragma unroll
    for (int mb = 0; mb < 2; ++mb) a[mb] = *(const bf16x8*)(ap + (size_t)mb * 16 * K);
#pragma unroll
    for (int nb = 0; nb < 8; ++nb) b[nb] = *(const bf16x8*)(bp + (size_t)nb * 16 * K);
    for (int s = w; s < nks; s += 8) {
        const bool more = (s + 8) < nks;
        bf16x8 an[2], bn[8];
        ap += 256; bp += 256;
        if (more) {
#pragma unroll
            for (int mb = 0; mb < 2; ++mb) an[mb] = *(const bf16x8*)(ap + (size_t)mb * 16 * K);
#pragma unroll
            for (int nb = 0; nb < 8; ++nb) bn[nb] = *(const bf16x8*)(bp + (size_t)nb * 16 * K);
        }
#pragma unroll
        for (int mb = 0; mb < 2; ++mb)
#pragma unroll
            for (int nb = 0; nb < 8; ++nb) acc[mb][nb] = MFMA16(b[nb], a[mb], acc[mb][nb]);
        if (more) {
#pragma unroll
            for (int mb = 0; mb < 2; ++mb) a[mb] = an[mb];
#pragma unroll
            for (int nb = 0; nb < 8; ++nb) b[nb] = bn[nb];
        }
    }
    constexpr int PST = 132;
    LAS float* part = (LAS float*)lds + w * (32 * PST);
#pragma unroll
    for (int mb = 0; mb < 2; ++mb)
#pragma unroll
        for (int nb = 0; nb < 8; ++nb) *(LAS f32x4*)(part + (16 * mb + fr) * PST + 16 * nb + 4 * fq) = acc[mb][nb];
    __syncthreads();
    const int r = tid >> 4, c8 = (tid & 15) * 8;
    f32x4 s0 = {0.f, 0.f, 0.f, 0.f}, s1 = {0.f, 0.f, 0.f, 0.f};
#pragma unroll
    for (int ww = 0; ww < 8; ++ww) { const LAS float* p = (const LAS float*)lds + ww * (32 * PST) + r * PST + c8; s0 += *(const LAS f32x4*)p; s1 += *(const LAS f32x4*)(p + 4); }
    const int row = row0 + r, col = col0 + c8;
    float* o = io + (size_t)row * DM + col;
    if (MODE == 0) {
        const float* xr = xs + (size_t)(row - NPROMPT) * DM + col;
        const f32x4 v0 = s0 + *(const f32x4*)xr, v1 = s1 + *(const f32x4*)(xr + 4);
        *(f32x4*)o = v0; *(f32x4*)(o + 4) = v1;
        float ss = (v0[0] * v0[0] + v0[1] * v0[1]) + (v0[2] * v0[2] + v0[3] * v0[3]) + (v1[0] * v1[0] + v1[1] * v1[1]) + (v1[2] * v1[2] + v1[3] * v1[3]);
        const f32x4 g0 = *(const f32x4*)(g2 + col), g1 = *(const f32x4*)(g2 + col + 4);
        *(v4u*)(h2 + (size_t)row * DM + col) = pack8(v0 * g0, v1 * g1);
        ss += __shfl_xor(ss, 1); ss += __shfl_xor(ss, 2); ss += __shfl_xor(ss, 4); ss += __shfl_xor(ss, 8);
        if ((tid & 15) == 0) { float* sp = ss2 + (size_t)row * 16 + 2 * (col0 >> 7); sp[0] = ss; sp[1] = 0.f; }
    } else {
        const f32x4 v0 = s0 + *(const f32x4*)o, v1 = s1 + *(const f32x4*)(o + 4);
        *(f32x4*)o = v0; *(f32x4*)(o + 4) = v1;
    }
    __syncthreads();
}

__device__ __forceinline__ void p0_transpose_item(const float* W, int K, int N, bf16* WT, int k0, int n0, int dst_row0, LAS float* scr, int lane) {
#pragma unroll 8
    for (int i = 0; i < 32; ++i) { const int kk = 2 * i + (lane >> 5); scr[kk * 33 + (lane & 31)] = W[(size_t)(k0 + kk) * N + n0 + (lane & 31)]; }
    LDS_WAIT(); asm volatile("" ::: "memory");
    const int c = lane & 7;
#pragma unroll
    for (int j = 0; j < 4; ++j) { const int n = (lane >> 3) + 8 * j; const LAS float* s = scr + (8 * c) * 33 + n;
        v4u o; o.x = cvt_pk_bf16(s[0 * 33], s[1 * 33]); o.y = cvt_pk_bf16(s[2 * 33], s[3 * 33]); o.z = cvt_pk_bf16(s[4 * 33], s[5 * 33]); o.w = cvt_pk_bf16(s[6 * 33], s[7 * 33]);
        *(v4u*)(WT + (size_t)(dst_row0 + n) * K + k0 + 8 * c) = o; }
    LDS_WAIT(); asm volatile("" ::: "memory");
}
__device__ __forceinline__ int win_dst(int s) {
    if (s < 1024) { const int sec = s >> 9, hh = (s & 511) >> 7, dpos = s & 127; return (sec * 2 + (hh >> 1)) * 256 + (dpos >> 6) * 128 + (hh & 1) * 64 + (dpos & 63); }
    if (s < 2560) return s;
    if (s < 3072) { const int i = s - 2560; return (10 + (i >> 7)) * 256 + (i & 127); }
    const int i = s - 3072; return (10 + (i >> 7)) * 256 + 128 + (i & 127);
}

struct Args { const float* in[14]; float* out; unsigned char* ws; int lo, hi; };

__global__ void __launch_bounds__(NWAVES * 64, 2) mk_fwd(Args a) {
    extern __shared__ __attribute__((aligned(16))) unsigned char lds_raw[];
    LAS unsigned char* lds = (LAS unsigned char*)lds_raw;
    const int tid = threadIdx.x, lane = tid & 63, wave = __builtin_amdgcn_readfirstlane(tid >> 6);
    const int G = gridDim.x, bx = blockIdx.x;
    const int lo = a.lo, hi = a.hi;
    const float *x_prompt = a.in[0], *x_sample = a.in[1], *state_conv = a.in[2], *state_ret = a.in[3], *norm1_g = a.in[4], *w_in = a.in[5], *conv_w = a.in[6],
                *ret_gn_g = a.in[7], *w_out = a.in[8], *norm2_g = a.in[9], *w_gate = a.in[10], *w_up = a.in[11], *w_down = a.in[12], *norm_f_g = a.in[13];
    unsigned char* ws = a.ws; float* out = a.out;
    bf16* Wt_in = (bf16*)(ws + WS_WIN); bf16* Wt_out = (bf16*)(ws + WS_WOUT); bf16* Wt_gu = (bf16*)(ws + WS_WGU); bf16* Wt_dn = (bf16*)(ws + WS_WDN);
    float* CS = (float*)(ws + WS_CS); float* SS2 = (float*)(ws + WS_SS2);
    bf16* XN = (bf16*)(ws + WS_XN); bf16* PROJ = (bf16*)(ws + WS_PROJ); bf16* ACT = (bf16*)(ws + WS_PROJ);
    float* KV = (float*)(ws + WS_KV); bf16* RS = (bf16*)(ws + WS_RS); bf16* MIX = (bf16*)(ws + WS_MIX);
#define IN(k) (lo <= (k) && (k) < hi)
    XcdBarrier bar; bar.bar = (unsigned*)(ws + WS_CTL); bar.x = 0; bar.st = nullptr;
    if (hi - lo > 1) {
        volatile LAS unsigned* misc = (volatile LAS unsigned*)(lds + MISC_OFF);
        if (tid < 32) misc[tid] = 0u;
        __syncthreads();
        bar = xcd_barrier_post((unsigned*)(ws + WS_CTL), misc + 8);
    }
#define SEAM(k) do { if (IN(k) && IN((k) + 1)) { xcd_barrier(bar); } } while (0)

    if (IN(0)) {
        LAS float* scr = (LAS float*)(lds + wave * 16384);
        const int gw = bx * NWAVES + wave, NGW = G * NWAVES;
        constexpr int I_IN = 16 * (NIN / 32), I_OUT = 16 * 32, I_G = 16 * (FF / 32), I_DN = (FF / 64) * 32;
        constexpr int NITEMS = I_IN + I_OUT + 2 * I_G + I_DN;
        for (int it = gw; it < NITEMS; it += NGW) {
            int r = it;
            if (r < I_IN) { const int kb = r / (NIN / 32), nb = r % (NIN / 32); p0_transpose_item(w_in, DM, NIN, Wt_in, 64 * kb, 32 * nb, win_dst(32 * nb), scr, lane); continue; } r -= I_IN;
            if (r < I_OUT) { const int kb = r / 32, nb = r % 32; p0_transpose_item(w_out, DM, DM, Wt_out, 64 * kb, 32 * nb, 32 * nb, scr, lane); continue; } r -= I_OUT;
            if (r < I_G) { const int kb = r / (FF / 32), nb = r % (FF / 32), s = 32 * nb; p0_transpose_item(w_gate, DM, FF, Wt_gu, 64 * kb, s, (s >> 7) * 256 + (s & 127), scr, lane); continue; } r -= I_G;
            if (r < I_G) { const int kb = r / (FF / 32), nb = r % (FF / 32), s = 32 * nb; p0_transpose_item(w_up, DM, FF, Wt_gu, 64 * kb, s, (s >> 7) * 256 + 128 + (s & 127), scr, lane); continue; } r -= I_G;
            { const int kb = r / 32, nb = r % 32; p0_transpose_item(w_down, FF, DM, Wt_dn, 64 * kb, 32 * nb, 32 * nb, scr, lane); }
        }
        for (int m = gw; m < M; m += NGW) {
            const float* xrow = m < NPROMPT ? x_prompt + (size_t)m * DM : x_sample + (size_t)(m - NPROMPT) * DM;
            const f32x4* xr = (const f32x4*)xrow + lane; f32x4 v[4]; float s = 0.f;
#pragma unroll
            for (int j = 0; j < 4; ++j) { v[j] = xr[64 * j]; s += (v[j][0] * v[j][0] + v[j][1] * v[j][1]) + (v[j][2] * v[j][2] + v[j][3] * v[j][3]); }
            const float r = rsqrtf(wave_sum(s) * (1.0f / DM) + 1e-6f);
            v2u* o8 = (v2u*)(XN + (size_t)m * DM) + lane;
#pragma unroll
            for (int j = 0; j < 4; ++j) { const f32x4 g = ((const f32x4*)norm1_g)[lane + 64 * j]; const f32x4 y = v[j] * r * g; v2u wv; wv.x = cvt_pk_bf16(y[0], y[1]); wv.y = cvt_pk_bf16(y[2], y[3]); o8[64 * j] = wv; }
        }
        for (int e = bx * 512 + tid; e < (SEQ + 8) * 64; e += G * 512) {
            const int p = e >> 6, i = e & 63;
            const double pos = p < SEQ ? (double)p : (double)(16384 + (p - SEQ));
            const double inv = exp2(-(double)i * (13.287712379549449 / 64.0));
            const double rev = pos * inv * 0.15915494309189535;
            const float fr_ = (float)(rev - floor(rev));
            CS[(size_t)p * 128 + i] = __builtin_amdgcn_cosf(fr_); CS[(size_t)p * 128 + 64 + i] = __builtin_amdgcn_sinf(fr_);
        }
    }
    SEAM(0);
    if (IN(1)) {
        pg8::Gemm g{XN, Wt_in, M, NIN, DM}; pg8::StaticOrder S; S.init(M, NIN, G, bx);
        EpiInProj E{PROJ, CS};
        pg8::gemm_phase<EpiInProj, pg8::StaticOrder, true, true>(lds, g, S, E);
    }
    SEAM(1);
    if (IN(2)) {
        for (int it = bx; it < 512; it += G) kv_unit(lds, PROJ, KV, it, tid);
        for (int it = bx; it < 512; it += G) sample_unit(lds, PROJ, state_ret, ret_gn_g, MIX, out + OUT_NRS, it, tid);
        for (int it = bx; it < M / 32; it += G) conv_unit(PROJ, state_conv, conv_w, MIX, out + OUT_NCP, out + OUT_NCS, it, tid);
    }
    SEAM(2);
    if (IN(3)) {
        for (int e4 = bx * 512 + tid; e4 < 32 * 4096; e4 += G * 512) {
            const int bh = e4 >> 12, dv = (e4 & 4095) * 4, h = bh & 3;
            const float g128 = __builtin_amdgcn_exp2f(128.0f * log2_gamma(h));
            const float* kvp = KV + (size_t)bh * 16 * 16384 + dv; bf16* rp = RS + (size_t)bh * 16 * 16384 + dv;
            f32x4 kvv[16];
#pragma unroll
            for (int c = 0; c < 16; ++c) kvv[c] = *(const f32x4*)(kvp + (size_t)c * 16384);
            f32x4 r = {0.f, 0.f, 0.f, 0.f};
#pragma unroll
            for (int c = 0; c < 16; ++c) { v2u wv; wv.x = cvt_pk_bf16(r[0], r[1]); wv.y = cvt_pk_bf16(r[2], r[3]); *(v2u*)(rp + (size_t)c * 16384) = wv; r = r * g128 + kvv[c]; }
            *(f32x4*)(out + OUT_NRP + (size_t)bh * 16384 + dv) = r;
        }
    }
    SEAM(3);
    if (IN(4)) {
        ro_phase(lds, PROJ, RS, ret_gn_g, MIX, bx, G, tid);
    }
    SEAM(4);
    if (IN(5)) {
        pg8::Gemm g{MIX, Wt_out, NPROMPT, DM, DM}; pg8::StaticOrder S; S.init(NPROMPT, DM, G, bx);
        EpiOut E{x_prompt, x_sample, out + OUT_Y, XN, norm2_g, SS2};
        pg8::gemm_phase<EpiOut, pg8::StaticOrder, true, true>(lds, g, S, E);
        for (int it = bx; it < 256; it += G) small_gemm_unit<0>(lds, MIX, Wt_out, DM, NPROMPT + (it >> 3) * 32, (it & 7) * 128, x_sample, out + OUT_Y, XN, norm2_g, SS2, tid);
    }
    SEAM(5);
    if (IN(6)) {
        pg8::Gemm g{XN, Wt_gu, M, NGU, DM}; pg8::StaticOrder S; S.init(M, NGU, G, bx);
        EpiGU E{SS2, ACT};
        pg8::gemm_phase<EpiGU, pg8::StaticOrder, true, true>(lds, g, S, E);
    }
    SEAM(6);
    if (IN(7)) {
        pg8::Gemm g{ACT, Wt_dn, NPROMPT, DM, FF}; pg8::StaticOrder S; S.init(NPROMPT, DM, G, bx);
        EpiDown E{out + OUT_Y};
        pg8::gemm_phase<EpiDown, pg8::StaticOrder, true, true>(lds, g, S, E);
        for (int it = bx; it < 256; it += G) small_gemm_unit<1>(lds, ACT, Wt_dn, FF, NPROMPT + (it >> 3) * 32, (it & 7) * 128, nullptr, out + OUT_Y, nullptr, nullptr, nullptr, tid);
    }
    SEAM(7);
    if (IN(8)) {
        const int gw = bx * NWAVES + wave, NGW = G * NWAVES;
        for (int m = gw; m < M; m += NGW) {
            f32x4* xr = (f32x4*)(out + OUT_Y + (size_t)m * DM) + lane; f32x4 v[4]; float s = 0.f;
#pragma unroll
            for (int j = 0; j < 4; ++j) { v[j] = xr[64 * j]; s += (v[j][0] * v[j][0] + v[j][1] * v[j][1]) + (v[j][2] * v[j][2] + v[j][3] * v[j][3]); }
            const float r = rsqrtf(wave_sum(s) * (1.0f / DM) + 1e-6f);
#pragma unroll
            for (int j = 0; j < 4; ++j) { const f32x4 g = ((const f32x4*)norm_f_g)[lane + 64 * j]; xr[64 * j] = v[j] * r * g; }
        }
    }
#undef IN
#undef SEAM
}

extern "C" void kernel_launch(void* const* d_in, const int* in_sizes, int n_in, void* d_out, int out_size, void* d_ws, size_t ws_size, hipStream_t stream) {
    static int grid = 0;
    if (grid == 0) {
        if (n_in != 14 || ws_size < WS_END) { fprintf(stderr, "kernel_launch: unexpected n_in %d / ws_size %zu\n", n_in, ws_size); grid = -1; return; }
        int dev = 0, cus = 0, per_cu = 0;
        if (hipGetDevice(&dev) != hipSuccess || hipDeviceGetAttribute(&cus, hipDeviceAttributeMultiprocessorCount, dev) != hipSuccess) { grid = -1; return; }
        if (hipFuncSetAttribute((const void*)mk_fwd, hipFuncAttributeMaxDynamicSharedMemorySize, LDS_BYTES) != hipSuccess) { fprintf(stderr, "kernel_launch: hipFuncSetAttribute failed\n"); grid = -1; return; }
        if (hipOccupancyMaxActiveBlocksPerMultiprocessor(&per_cu, (const void*)mk_fwd, NWAVES * 64, LDS_BYTES) != hipSuccess || per_cu < 1) { fprintf(stderr, "kernel_launch: occupancy query gave %d\n", per_cu); (void)hipGetLastError(); per_cu = 1; }
        grid = cus * per_cu;
    }
    if (grid < 0) return;
    if (hipMemsetAsync((char*)d_ws + WS_CTL, 0, CTL_BYTES, stream) != hipSuccess) { fprintf(stderr, "kernel_launch: memset failed\n"); return; }
    Args a{};
    for (int i = 0; i < 14; ++i) a.in[i] = (const float*)d_in[i];
    a.out = (float*)d_out; a.ws = (unsigned char*)d_ws;
#if MK_N_LAUNCHES == 1
    a.lo = 0; a.hi = NPHASE;
    void* args[] = {&a};
    hipError_t e = hipLaunchCooperativeKernel((const void*)mk_fwd, dim3(grid), dim3(NWAVES * 64), args, LDS_BYTES, stream);
    if (e != hipSuccess) fprintf(stderr, "kernel_launch: cooperative launch failed: %s (grid %d)\n", hipGetErrorString(e), grid);
#else
#ifdef MK_PROBE_SEQ
    const int seq[] = MK_PROBE_SEQ;
    for (int p : seq) {
#else
    for (int p = 0; p < NPHASE; ++p) {
#endif
        a.lo = p; a.hi = p + 1;
        hipLaunchKernelGGL(mk_fwd, dim3(grid), dim3(NWAVES * 64), LDS_BYTES, stream, a);
    }
#endif
}
```

```cpp
#include <hip/hip_runtime.h>
#include <hip/hip_cooperative_groups.h>
#include <cstdio>
#include <cstdint>
namespace cg = cooperative_groups;
#define MK_N_LAUNCHES 1
namespace pg8 {
#define PG8_LAS __attribute__((address_space(3)))
typedef unsigned short bf16_t;
typedef short bf16x8 __attribute__((ext_vector_type(8)));
typedef float f32x4 __attribute__((ext_vector_type(4)));
typedef unsigned u32x4 __attribute__((ext_vector_type(4)));
constexpr int BM = 256, BK = 64, HALF = 128, HTB = HALF * BK * 2  , STAGE_BYTES = 8 * HTB, NXCD = 8, WGM = 8;

__host__ __device__ __forceinline__ int lds_byte(int r, int c) { const int st = (r >> 4) * 2 + (c >> 5), rr = r & 15, cc = c & 31, ob = rr * 64 + cc * 2; return st * 1024 + (ob ^ (((ob >> 9) & 1) << 5)); }
__host__ __device__ __forceinline__ void stage_rc(int b, int& R, int& C) { const int st = b / 1024, sb = b % 1024, swz = sb ^ (((sb >> 9) & 1) << 5); R = (st >> 1) * 16 + swz / 64; C = (st & 1) * 32 + (swz % 64) / 2; }
__host__ __device__ __forceinline__ int perm32(int rho) { const int n = rho >> 4, i = rho & 15; return 8 * (i >> 2) + 4 * n + (i & 3); }

struct Unit { int pm, pn; };
struct Gemm { const bf16_t* A; const bf16_t* Bt; int M, N, K; };

struct StaticOrder {
    int nM, nN, nwg, G, c;
    __host__ __device__ void init(int M, int N, int G_, int c_) { nM = M / BM; nN = N / BM; nwg = nM * nN; G = G_; c = c_; }
    __host__ __device__ bool next(int i, Unit& u) const {
        const long L = (long)i * G + c; if (L >= nwg) return false;
        int wgid = (int)L; { const int q = nwg / NXCD, r = nwg % NXCD, xcd = wgid % NXCD, off = wgid / NXCD; wgid = (xcd < r ? xcd * (q + 1) : r * (q + 1) + (xcd - r) * q) + off; }
        const int nig = WGM * nN, gid = wgid / nig, fm = gid * WGM, gsz = (nM - fm) < WGM ? (nM - fm) : WGM;
        u.pm = fm + ((wgid % nig) % gsz); u.pn = (wgid % nig) / gsz; return true;
    }
    __device__ __forceinline__ void a_ready(const Unit&) const {}
    __device__ __forceinline__ void done(const Unit&) const {}
};

__device__ __forceinline__ unsigned cvt_pk_bf16(float lo, float hi) { unsigned r; asm volatile("v_cvt_pk_bf16_f32 %0, %1, %2" : "=v"(r) : "v"(lo), "v"(hi)); return r; }
template <class Epi, class Sched, bool ALIGN_EPI = false, bool SP2 = false>
__device__ __forceinline__ void gemm_phase(PG8_LAS unsigned char* lds, const Gemm g, const Sched& S, const Epi& E) {
    const int tid = threadIdx.x, wid = __builtin_amdgcn_readfirstlane(tid >> 6), lane = tid & 63, wr = wid >> 2, wc = wid & 3, fr = lane & 15, fq = lane >> 4;
    const int K = g.K, nt = K / BK;
    unsigned voffA[2], voffB[2];
#pragma unroll
    for (int i = 0; i < 2; ++i) { int R, C; stage_rc(tid * 16 + i * 8192, R, C); const int Rb = Epi::PERM ? ((R & ~31) + perm32(R & 31)) : R;
        voffA[i] = (unsigned)(R * K + C) * 2u; voffB[i] = (unsigned)(Rb * K + C) * 2u; }
    const size_t kstep = (size_t)(BK * 2);
    const size_t hstep = (size_t)HALF * K * 2;
    const size_t tstep = 2 * hstep;
    const unsigned ldsw = (unsigned)wid * 1024u;
    const int aoff = lds_byte(wr * 64 + fr, fq * 8), boff = lds_byte(wc * 32 + fr, fq * 8);
#define PG8_SA(b, h) (((b) * 2 + (h)) * HTB)
#define PG8_SB(b, h) ((4 + (b) * 2 + (h)) * HTB)
#define PG8_STAGE(bufoff, gbase, voff) do { _Pragma("unroll") for (int _i = 0; _i < 2; ++_i) \
        __builtin_amdgcn_global_load_lds((const unsigned*)((const char*)(gbase) + (voff)[_i]), (PG8_LAS unsigned*)(lds + (bufoff) + ldsw + _i * 8192), 16, 0, 0); } while (0)
#define PG8_LDA(dst, b, h) do { _Pragma("unroll") for (int m = 0; m < 4; ++m) _Pragma("unroll") for (int k = 0; k < 2; ++k) dst[m][k] = *(const PG8_LAS bf16x8*)(lds + PG8_SA(b, h) + aoff + m * 2048 + k * 1024); } while (0)
#define PG8_LDB(dst, b, h) do { _Pragma("unroll") for (int n = 0; n < 2; ++n) _Pragma("unroll") for (int k = 0; k < 2; ++k) dst[n][k] = *(const PG8_LAS bf16x8*)(lds + PG8_SB(b, h) + boff + n * 2048 + k * 1024); } while (0)
#define PG8_MMA(ai, bj, At, Bt) do { __builtin_amdgcn_s_setprio(1); _Pragma("unroll") for (int m = 0; m < 4; ++m) _Pragma("unroll") for (int n = 0; n < 2; ++n) _Pragma("unroll") for (int k = 0; k < 2; ++k) \
        acc[ai][bj][m][n] = __builtin_amdgcn_mfma_f32_16x16x32_bf16(Bt[n][k], At[m][k], acc[ai][bj][m][n], 0, 0, 0); __builtin_amdgcn_s_setprio(0); } while (0)
#define PG8_WAIT_V(n) asm volatile("s_waitcnt vmcnt(" #n ")" ::: "memory")
#define PG8_WAIT_L(n) asm volatile("s_waitcnt lgkmcnt(" #n ")" ::: "memory")
#define PG8_BAR __builtin_amdgcn_s_barrier()
#define PG8_SCHED __builtin_amdgcn_sched_barrier(0)
    Unit cur, nxt; int ui = 0;
    if (!S.next(0, cur)) return;
    f32x4 acc[2][2][4][2];
#pragma unroll
    for (int a = 0; a < 2; ++a)
#pragma unroll
        for (int b = 0; b < 2; ++b)
#pragma unroll
            for (int m = 0; m < 4; ++m)
#pragma unroll
                for (int n = 0; n < 2; ++n) acc[a][b][m][n] = (f32x4){0.f, 0.f, 0.f, 0.f};
    bf16x8 At[4][2], B0[2][2], B1[2][2];
    const char* cA = (const char*)g.A + (size_t)cur.pm * tstep; const char* cB = (const char*)g.Bt + (size_t)cur.pn * tstep;
    S.a_ready(cur);
    if constexpr (SP2) {
        PG8_STAGE(PG8_SB(0, 0), cB, voffB); PG8_STAGE(PG8_SB(0, 1), cB + hstep, voffB); PG8_STAGE(PG8_SA(0, 0), cA, voffA); PG8_STAGE(PG8_SA(0, 1), cA + hstep, voffA);
        if (wr == 1) PG8_BAR;
        PG8_WAIT_V(2); PG8_BAR;
        PG8_STAGE(PG8_SB(1, 0), cB + kstep, voffB); PG8_STAGE(PG8_SA(1, 0), cA + kstep, voffA); PG8_STAGE(PG8_SB(1, 1), cB + hstep + kstep, voffB);
        PG8_WAIT_V(6); PG8_BAR;
    } else {
        PG8_STAGE(PG8_SB(0, 0), cB, voffB); PG8_STAGE(PG8_SA(0, 0), cA, voffA); PG8_STAGE(PG8_SB(0, 1), cB + hstep, voffB); PG8_STAGE(PG8_SA(0, 1), cA + hstep, voffA);
        if (wr == 1) PG8_BAR;
        PG8_WAIT_V(4); PG8_BAR;
        PG8_STAGE(PG8_SB(1, 0), cB + kstep, voffB); PG8_STAGE(PG8_SA(1, 0), cA + kstep, voffA); PG8_STAGE(PG8_SB(1, 1), cB + hstep + kstep, voffB);
        PG8_WAIT_V(6); PG8_BAR;
    }
    for (;;) {
        const bool has_next = S.next(ui + 1, nxt);
        const char* nA = has_next ? (const char*)g.A + (size_t)nxt.pm * tstep : cA; const char* nB = has_next ? (const char*)g.Bt + (size_t)nxt.pn * tstep : cB;
        for (int t = 0; t < nt; t += 2) {
            const bool last = (t == nt - 2);
            const char* a1 = cA + (size_t)(t + 1) * kstep;
            const char* a2 = last ? nA : cA + (size_t)(t + 2) * kstep; const char* b2 = last ? nB : cB + (size_t)(t + 2) * kstep;
            const char* a3 = a2 + kstep; const char* b3 = b2 + kstep;
            if (last && has_next) S.a_ready(nxt);
            if constexpr (SP2) {
            PG8_LDB(B0, 0, 0); PG8_LDB(B1, 0, 1); PG8_SCHED; PG8_LDA(At, 0, 0); PG8_STAGE(PG8_SA(1, 1), a1 + hstep, voffA);
            PG8_WAIT_V(8); PG8_WAIT_L(0); PG8_BAR; PG8_MMA(0, 0, At, B0); PG8_MMA(0, 1, At, B1); PG8_BAR; PG8_SCHED;
            PG8_LDA(At, 0, 1); PG8_STAGE(PG8_SB(0, 0), b2, voffB); PG8_STAGE(PG8_SB(0, 1), b2 + hstep, voffB); PG8_STAGE(PG8_SA(0, 0), a2, voffA);
            PG8_WAIT_V(8); PG8_WAIT_L(0); PG8_BAR; PG8_MMA(1, 0, At, B0); PG8_MMA(1, 1, At, B1); PG8_BAR; PG8_SCHED;
            PG8_LDB(B0, 1, 0); PG8_LDB(B1, 1, 1); PG8_SCHED; PG8_LDA(At, 1, 0); PG8_STAGE(PG8_SA(0, 1), a2 + hstep, voffA);
            PG8_WAIT_V(8); PG8_WAIT_L(0); PG8_BAR; PG8_MMA(0, 0, At, B0); PG8_MMA(0, 1, At, B1); PG8_BAR; PG8_SCHED;
            PG8_LDA(At, 1, 1); PG8_STAGE(PG8_SB(1, 0), b3, voffB); PG8_STAGE(PG8_SB(1, 1), b3 + hstep, voffB); PG8_STAGE(PG8_SA(1, 0), a3, voffA);
            PG8_WAIT_V(8); PG8_WAIT_L(0); PG8_BAR; PG8_MMA(1, 0, At, B0); PG8_MMA(1, 1, At, B1); PG8_BAR; PG8_SCHED;
            } else {
            PG8_LDB(B0, 0, 0); PG8_SCHED; PG8_LDA(At, 0, 0); PG8_STAGE(PG8_SA(1, 1), a1 + hstep, voffA);
            PG8_WAIT_L(8); PG8_BAR; PG8_WAIT_L(0); PG8_MMA(0, 0, At, B0); PG8_BAR; PG8_SCHED;
            PG8_LDB(B1, 0, 1); PG8_STAGE(PG8_SB(0, 0), b2, voffB);
            PG8_BAR; PG8_WAIT_L(0); PG8_MMA(0, 1, At, B1); PG8_BAR;
            PG8_LDA(At, 0, 1); PG8_STAGE(PG8_SA(0, 0), a2, voffA);
            PG8_BAR; PG8_WAIT_L(0); PG8_MMA(1, 0, At, B0); PG8_BAR; PG8_SCHED;
            PG8_STAGE(PG8_SB(0, 1), b2 + hstep, voffB);
            PG8_WAIT_V(6); PG8_BAR; PG8_MMA(1, 1, At, B1); PG8_BAR;
            PG8_LDB(B0, 1, 0); PG8_SCHED; PG8_LDA(At, 1, 0); PG8_STAGE(PG8_SA(0, 1), a2 + hstep, voffA);
            PG8_WAIT_L(8); PG8_BAR; PG8_WAIT_L(0); PG8_MMA(0, 0, At, B0); PG8_BAR; PG8_SCHED;
            PG8_LDB(B1, 1, 1); PG8_STAGE(PG8_SB(1, 0), b3, voffB);
            PG8_BAR; PG8_WAIT_L(0); PG8_MMA(0, 1, At, B1); PG8_BAR;
            PG8_LDA(At, 1, 1); PG8_STAGE(PG8_SA(1, 0), a3, voffA);
            PG8_BAR; PG8_WAIT_L(0); PG8_MMA(1, 0, At, B0); PG8_BAR; PG8_SCHED;
            PG8_STAGE(PG8_SB(1, 1), b3 + hstep, voffB);
            PG8_WAIT_V(6); PG8_BAR; PG8_MMA(1, 1, At, B1); PG8_BAR;
            }
        }
        if constexpr (ALIGN_EPI) { if (wr == 0) PG8_BAR; }
        if constexpr (!Epi::AFTER_DRAIN) { E(acc, cur, wr, wc, fr, fq); S.done(cur); }
        if (!has_next) break;
#pragma unroll
        for (int a = 0; a < 2; ++a)
#pragma unroll
            for (int b = 0; b < 2; ++b)
#pragma unroll
                for (int m = 0; m < 4; ++m)
#pragma unroll
                    for (int n = 0; n < 2; ++n) acc[a][b][m][n] = (f32x4){0.f, 0.f, 0.f, 0.f};
        cur = nxt; cA = nA; cB = nB; ++ui;
        if constexpr (ALIGN_EPI) { if (wr == 1) PG8_BAR; }
    }
    PG8_WAIT_V(0);
    if constexpr (!ALIGN_EPI) { if (wr == 0) PG8_BAR; }
    PG8_BAR;
    if constexpr (Epi::AFTER_DRAIN) { E.fused(acc, cur, wr, wc, fr, fq, lds, wid, lane); S.done(cur); }
#undef PG8_SA
#undef PG8_SB
#undef PG8_STAGE
#undef PG8_LDA
#undef PG8_LDB
#undef PG8_MMA
#undef PG8_WAIT_V
#undef PG8_WAIT_L
#undef PG8_BAR
#undef PG8_SCHED
}
}

#ifndef MK_N_LAUNCHES
#define MK_N_LAUNCHES 1
#endif
constexpr int DM = 1024, NPROMPT = 16384, M = 17408, SEQ = 2048;
constexpr int NIN = 3584, PROJW = 3072, FF = 2816, NGU = 5632;
constexpr int NPHASE = 9;
constexpr int NWAVES = 8;
constexpr size_t MiB = 1u << 20;
constexpr size_t WS_WIN = 0, WS_WOUT = 7 * MiB, WS_WGU = 9 * MiB, WS_WDN = 20 * MiB, WS_CS = 26 * MiB, WS_SS2 = 28 * MiB;
constexpr size_t WS_XN = 30 * MiB;
constexpr size_t WS_PROJ = 64 * MiB;
constexpr size_t WS_KV = 166 * MiB;
constexpr size_t WS_RS = 198 * MiB;
constexpr size_t WS_MIX = 214 * MiB;
constexpr size_t WS_END = 248 * MiB;
constexpr int LDS_BYTES = 147456, MISC_OFF = 143360;
constexpr size_t WS_CTL = 29 * MiB + 512 * 1024, CTL_BYTES = 16384;
constexpr size_t OUT_Y = 0, OUT_NCP = (size_t)M * DM, OUT_NRP = OUT_NCP + 8192, OUT_NCS = OUT_NRP + 524288, OUT_NRS = OUT_NCS + 131072;

constexpr size_t KS = (size_t)M * 512;
constexpr int BUW = 1024;
__device__ __forceinline__ size_t tokoff(int row, int head) {
    if (row < NPROMPT) return ((size_t)(((row >> 11) * 4 + head) * SEQ + (row & (SEQ - 1)))) * 128;
    const int ms = row - NPROMPT; return (size_t)NPROMPT * 512 + ((size_t)((((ms >> 3) * 4 + head) * 8) + (ms & 7))) * 128;
}
#define GAS __attribute__((address_space(1)))
#define LAS __attribute__((address_space(3)))
typedef unsigned short bf16;
typedef unsigned v4u __attribute__((ext_vector_type(4)));
typedef unsigned v2u __attribute__((ext_vector_type(2)));
typedef float f32x4 __attribute__((ext_vector_type(4)));
typedef short bf16x8 __attribute__((ext_vector_type(8)));
typedef short s16x4 __attribute__((ext_vector_type(4)));
using pg8::cvt_pk_bf16;
#define LDS_WAIT() asm volatile("s_waitcnt lgkmcnt(0)" ::: "memory")

__device__ __forceinline__ float bf2f(unsigned h) { return __builtin_bit_cast(float, h << 16); }
__device__ __forceinline__ float bflo(unsigned w) { return __builtin_bit_cast(float, w << 16); }
__device__ __forceinline__ float bfhi(unsigned w) { return __builtin_bit_cast(float, w & 0xffff0000u); }
__device__ __forceinline__ v4u pack8(f32x4 a, f32x4 b) { v4u w; w.x = cvt_pk_bf16(a[0], a[1]); w.y = cvt_pk_bf16(a[2], a[3]); w.z = cvt_pk_bf16(b[0], b[1]); w.w = cvt_pk_bf16(b[2], b[3]); return w; }
__device__ __forceinline__ void unpack8(v4u w, f32x4& a, f32x4& b) { a = (f32x4){bflo(w.x), bfhi(w.x), bflo(w.y), bfhi(w.y)}; b = (f32x4){bflo(w.z), bfhi(w.z), bflo(w.w), bfhi(w.w)}; }
__device__ __forceinline__ float wave_sum(float v) {
#pragma unroll
    for (int o = 1; o < 64; o <<= 1) v += __shfl_xor(v, o);
    return v;
}
__device__ __forceinline__ float silu_f(float x) { return x * __builtin_amdgcn_rcpf(1.0f + __builtin_amdgcn_exp2f(-1.4426950408889634f * x)); }
__device__ __forceinline__ float log2_gamma(int h) { return log2f(1.0f - exp2f(-5.0f - (float)h)); }

struct EpiInProj {
    static constexpr bool PERM = true, AFTER_DRAIN = false;
    bf16* P; const float* cs;
    __device__ __forceinline__ void operator()(const f32x4 (&acc)[2][2][4][2], const pg8::Unit& u, int wr, int wc, int fr, int fq) const {
        const int pn = u.pn, cgp = wc * 32 + 8 * fq, rowb = u.pm * 256 + wr * 64 + fr;
        if (pn < 4) {
            const int sec = pn >> 1, head = 2 * (pn & 1) + (cgp >> 6), dd = cgp & 63;
            const float sc = sec ? 0.08838834764831845f : 1.0f;
#pragma unroll
            for (int ai = 0; ai < 2; ++ai)
#pragma unroll
                for (int m = 0; m < 4; ++m) {
                    const int row = rowb + ai * 128 + m * 16;
                    const int pidx = row < NPROMPT ? (row & (SEQ - 1)) : SEQ + (row & 7);
                    const float* t = cs + (size_t)pidx * 128 + dd;
                    const f32x4 c0 = *(const f32x4*)t, c1 = *(const f32x4*)(t + 4), s0 = *(const f32x4*)(t + 64), s1 = *(const f32x4*)(t + 68);
                    const f32x4 a0 = acc[ai][0][m][0], a1 = acc[ai][0][m][1], b0 = acc[ai][1][m][0], b1 = acc[ai][1][m][1];
                    bf16* o = P + (size_t)sec * KS + tokoff(row, head) + dd;
                    *(v4u*)o = pack8((a0 * c0 - b0 * s0) * sc, (a1 * c1 - b1 * s1) * sc);
                    *(v4u*)(o + 64) = pack8((a0 * s0 + b0 * c0) * sc, (a1 * s1 + b1 * c1) * sc);
                }
        } else if (pn < 8) {
            const int kind = 2 + ((pn - 4) >> 1), h0 = (pn & 1) * 2;
#pragma unroll
            for (int ai = 0; ai < 2; ++ai)
#pragma unroll
                for (int m = 0; m < 4; ++m) {
                    const int row = rowb + ai * 128 + m * 16;
                    bf16* o = P + (size_t)kind * KS + tokoff(row, h0) + cgp;
                    *(v4u*)o = pack8(acc[ai][0][m][0], acc[ai][0][m][1]);
                    *(v4u*)(o + (tokoff(row, h0 + 1) - tokoff(row, h0))) = pack8(acc[ai][1][m][0], acc[ai][1][m][1]);
                }
        } else if (pn < 10) {
#pragma unroll
            for (int ai = 0; ai < 2; ++ai)
#pragma unroll
                for (int m = 0; m < 4; ++m) {
                    const int row = rowb + ai * 128 + m * 16;
                    bf16* o = P + 4 * KS + (size_t)row * BUW + (pn - 8) * 256 + cgp;
                    *(v4u*)o = pack8(acc[ai][0][m][0], acc[ai][0][m][1]);
                    *(v4u*)(o + 128) = pack8(acc[ai][1][m][0], acc[ai][1][m][1]);
                }
        } else {
#pragma unroll
            for (int ai = 0; ai < 2; ++ai)
#pragma unroll
                for (int m = 0; m < 4; ++m) {
                    const int row = rowb + ai * 128 + m * 16;
                    bf16* o = P + 4 * KS + (size_t)row * BUW + 512 + (pn - 10) * 128 + cgp;
                    *(v4u*)o = pack8(acc[ai][0][m][0] * acc[ai][1][m][0], acc[ai][0][m][1] * acc[ai][1][m][1]);
                }
        }
    }
};
struct EpiOut {
    static constexpr bool PERM = true, AFTER_DRAIN = false;
    const float* xp; const float* xs; float* x1; bf16* h2; const float* g2; float* ss2;
    __device__ __forceinline__ void operator()(const f32x4 (&acc)[2][2][4][2], const pg8::Unit& u, int wr, int wc, int fr, int fq) const {
        const int cgp = wc * 32 + 8 * fq, rowb = u.pm * 256 + wr * 64 + fr;
#pragma unroll
        for (int ai = 0; ai < 2; ++ai)
#pragma unroll
            for (int m = 0; m < 4; ++m) {
                const int row = rowb + ai * 128 + m * 16;
                const float* xr = row < NPROMPT ? xp + (size_t)row * DM : xs + (size_t)(row - NPROMPT) * DM;
                float ss = 0.f;
#pragma unroll
                for (int bj = 0; bj < 2; ++bj) {
                    const int col = u.pn * 256 + bj * 128 + cgp;
                    const f32x4 v0 = acc[ai][bj][m][0] + *(const f32x4*)(xr + col), v1 = acc[ai][bj][m][1] + *(const f32x4*)(xr + col + 4);
                    float* o = x1 + (size_t)row * DM + col;
                    *(f32x4*)o = v0; *(f32x4*)(o + 4) = v1;
                    ss += (v0[0] * v0[0] + v0[1] * v0[1]) + (v0[2] * v0[2] + v0[3] * v0[3]) + (v1[0] * v1[0] + v1[1] * v1[1]) + (v1[2] * v1[2] + v1[3] * v1[3]);
                    const f32x4 g0 = *(const f32x4*)(g2 + col), g1 = *(const f32x4*)(g2 + col + 4);
                    *(v4u*)(h2 + (size_t)row * DM + col) = pack8(v0 * g0, v1 * g1);
                }
                ss += __shfl_xor(ss, 16); ss += __shfl_xor(ss, 32);
                if (fq == 0) ss2[(size_t)row * 16 + u.pn * 4 + wc] = ss;
            }
    }
};
struct EpiGU {
    static constexpr bool PERM = true, AFTER_DRAIN = false;
    const float* ss2; bf16* act;
    __device__ __forceinline__ void operator()(const f32x4 (&acc)[2][2][4][2], const pg8::Unit& u, int wr, int wc, int fr, int fq) const {
        const int cgp = wc * 32 + 8 * fq, rowb = u.pm * 256 + wr * 64 + fr;
#pragma unroll
        for (int ai = 0; ai < 2; ++ai)
#pragma unroll
            for (int m = 0; m < 4; ++m) {
                const int row = rowb + ai * 128 + m * 16;
                const f32x4* sp = (const f32x4*)(ss2 + (size_t)row * 16);
                const f32x4 p0 = sp[0], p1 = sp[1], p2 = sp[2], p3 = sp[3];
                const f32x4 ps = (p0 + p1) + (p2 + p3);
                const float r = rsqrtf(((ps[0] + ps[1]) + (ps[2] + ps[3])) * (1.0f / DM) + 1e-6f);
                f32x4 o[2];
#pragma unroll
                for (int n = 0; n < 2; ++n) {
                    const f32x4 g = acc[ai][0][m][n] * r, up = acc[ai][1][m][n] * r;
                    o[n] = (f32x4){silu_f(g[0]) * up[0], silu_f(g[1]) * up[1], silu_f(g[2]) * up[2], silu_f(g[3]) * up[3]};
                }
                *(v4u*)(act + (size_t)row * FF + u.pn * 128 + cgp) = pack8(o[0], o[1]);
            }
    }
};
struct EpiDown {
    static constexpr bool PERM = true, AFTER_DRAIN = false;
    float* io;
    __device__ __forceinline__ void operator()(const f32x4 (&acc)[2][2][4][2], const pg8::Unit& u, int wr, int wc, int fr, int fq) const {
        const int cgp = wc * 32 + 8 * fq, rowb = u.pm * 256 + wr * 64 + fr;
#pragma unroll
        for (int ai = 0; ai < 2; ++ai)
#pragma unroll
            for (int m = 0; m < 4; ++m) {
                const int row = rowb + ai * 128 + m * 16;
#pragma unroll
                for (int bj = 0; bj < 2; ++bj) {
                    float* o = io + (size_t)row * DM + u.pn * 256 + bj * 128 + cgp;
                    const f32x4 v0 = acc[ai][bj][m][0] + *(const f32x4*)o, v1 = acc[ai][bj][m][1] + *(const f32x4*)(o + 4);
                    *(f32x4*)o = v0; *(f32x4*)(o + 4) = v1;
                }
            }
    }
};

__device__ __forceinline__ unsigned off_b(unsigned row, unsigned ch) { return 256u * row + 16u * (ch ^ (((row & 3u) << 2) | ((row >> 2) & 3u))); }
__device__ __forceinline__ unsigned row_addr16(unsigned lane, unsigned rb, unsigned s) { return off_b((lane & 15u) + 16u * rb, 4u * s + (lane >> 4)); }
__device__ __forceinline__ unsigned tr_addr16(unsigned lane, unsigned c, unsigned ks, unsigned t) {
    const unsigned g = lane >> 4, q = (lane & 15u) >> 2, p = lane & 3u;
    return off_b(32u * ks + 8u * g + 4u * t + q, 2u * c + (p >> 1)) + 8u * (p & 1u);
}
__device__ __forceinline__ void tr_frags4(unsigned img, unsigned lane, unsigned c, bf16x8 (&f)[4]) {
    const unsigned a0 = img + tr_addr16(lane, c, 0, 0), a1 = img + tr_addr16(lane, c, 0, 1);
    s16x4 r0, r1, r2, r3, r4, r5, r6, r7;
    asm volatile("ds_read_b64_tr_b16 %0, %8\n\t"
                 "ds_read_b64_tr_b16 %1, %9\n\t"
                 "ds_read_b64_tr_b16 %2, %8 offset:8192\n\t"
                 "ds_read_b64_tr_b16 %3, %9 offset:8192\n\t"
                 "ds_read_b64_tr_b16 %4, %8 offset:16384\n\t"
                 "ds_read_b64_tr_b16 %5, %9 offset:16384\n\t"
                 "ds_read_b64_tr_b16 %6, %8 offset:24576\n\t"
                 "ds_read_b64_tr_b16 %7, %9 offset:24576\n\t"
                 "s_waitcnt lgkmcnt(0)"
                 : "=&v"(r0), "=&v"(r1), "=&v"(r2), "=&v"(r3), "=&v"(r4), "=&v"(r5), "=&v"(r6), "=&v"(r7)
                 : "v"(a0), "v"(a1) : "memory");
    f[0] = (bf16x8){r0[0], r0[1], r0[2], r0[3], r1[0], r1[1], r1[2], r1[3]};
    f[1] = (bf16x8){r2[0], r2[1], r2[2], r2[3], r3[0], r3[1], r3[2], r3[3]};
    f[2] = (bf16x8){r4[0], r4[1], r4[2], r4[3], r5[0], r5[1], r5[2], r5[3]};
    f[3] = (bf16x8){r6[0], r6[1], r6[2], r6[3], r7[0], r7[1], r7[2], r7[3]};
}
#define MFMA16(a, b, c) __builtin_amdgcn_mfma_f32_16x16x32_bf16((a), (b), (c), 0, 0, 0)

template <bool SCALE>
__device__ __forceinline__ void stage_tile(LAS unsigned char* img, const bf16* src, size_t pitch, int tid, float zl) {
    v4u v[4];
#pragma unroll
    for (int k = 0; k < 4; ++k) { const int id = tid + 512 * k, row = id >> 4, ch = id & 15; v[k] = *(const v4u*)(src + (size_t)row * pitch + ch * 8); }
#pragma unroll
    for (int k = 0; k < 4; ++k) { const int id = tid + 512 * k, row = id >> 4, ch = id & 15;
        v4u w = v[k];
        if (SCALE) { f32x4 a, b; unpack8(w, a, b); const float z = __builtin_amdgcn_exp2f((float)(127 - row) * zl); w = pack8(a * z, b * z); }
        *(LAS v4u*)(img + off_b(row, ch)) = w; }
}

__device__ __forceinline__ void kv_unit(LAS unsigned char* lds, const bf16* proj, float* kv, int unit, int tid) {
    const int b = unit >> 6, h = (unit >> 4) & 3, c = unit & 15, row0 = b * SEQ + c * 128;
    const int lane = tid & 63, w = __builtin_amdgcn_readfirstlane(tid >> 6), fr = lane & 15, fq = lane >> 4;
    const float l2g = log2_gamma(h);
    LAS unsigned char* Kimg = lds; LAS unsigned char* Vimg = lds + 32768;
    const size_t tb = ((size_t)((b * 4 + h) * SEQ + c * 128)) * 128;
    stage_tile<true>(Kimg, proj + KS + tb, 128, tid, l2g);
    stage_tile<false>(Vimg, proj + 2 * KS + tb, 128, tid, 0.f);
    __syncthreads();
    bf16x8 aK[4]; tr_frags4((unsigned)(size_t)Kimg, lane, w, aK);
    float* o = kv + (size_t)unit * 16384 + (size_t)(16 * w + 4 * fq) * 128 + fr;
#pragma unroll
    for (int nb = 0; nb < 8; ++nb) {
        bf16x8 bV[4]; tr_frags4((unsigned)(size_t)Vimg, lane, nb, bV);
        f32x4 acc = {0.f, 0.f, 0.f, 0.f};
#pragma unroll
        for (int s = 0; s < 4; ++s) acc = MFMA16(aK[s], bV[s], acc);
#pragma unroll
        for (int e = 0; e < 4; ++e) o[e * 128 + nb * 16] = acc[e];
    }
    __syncthreads();
}

__device__ __forceinline__ void sample_unit(LAS unsigned char* lds, const bf16* proj, const float* state_ret, const float* gn_g, bf16* mix, float* new_ret, int unit, int tid) {
    const int b = unit >> 2, h = unit & 3, row0 = NPROMPT + b * 8;
    const int lane = tid & 63, w = __builtin_amdgcn_readfirstlane(tid >> 6);
    LAS float* qT = (LAS float*)lds;
    LAS float* kzT = qT + 1024;
    LAS float* kT = kzT + 1024;
    LAS float* vs = kT + 1024;
    LAS float* sc = vs + 1024;
    LAS float* po = sc + 64;
    const float l2g = log2_gamma(h);
#pragma unroll
    for (int k2 = 0; k2 < 2; ++k2) {
        const int e = tid + 512 * k2, i = e >> 7, d = e & 127;
        const bf16* base = proj + tokoff(row0 + i, h) + d;
        const float q = bf2f(base[0]), k = bf2f(base[KS]), v = bf2f(base[2 * KS]);
        qT[d * 8 + i] = q; kT[d * 8 + i] = k; kzT[d * 8 + i] = k * __builtin_amdgcn_exp2f((float)(7 - i) * l2g); vs[i * 128 + d] = v;
    }
    __syncthreads();
    if (tid < 64) {
        const int i = tid >> 3, j = tid & 7; float s = 0.f;
        for (int d = 0; d < 128; ++d) s += qT[d * 8 + i] * kT[d * 8 + j];
        sc[i * 8 + j] = (j <= i) ? s * __builtin_amdgcn_exp2f((float)(i - j) * l2g) : 0.f;
    }
    const int v4 = (tid & 31) * 4, dg = tid >> 5;
    f32x4 vv[8], pacc[8];
#pragma unroll
    for (int j = 0; j < 8; ++j) { vv[j] = *(const LAS f32x4*)(vs + j * 128 + v4); pacc[j] = (f32x4){0.f, 0.f, 0.f, 0.f}; }
    const float g8 = __builtin_amdgcn_exp2f(8.0f * l2g);
    const float* Rin = state_ret + (size_t)(b * 4 + h) * 16384 + v4;
    float* Rout = new_ret + (size_t)(b * 4 + h) * 16384 + v4;
    f32x4 rr[8];
#pragma unroll
    for (int dd = 0; dd < 8; ++dd) rr[dd] = *(const f32x4*)(Rin + (size_t)(dg * 8 + dd) * 128);
#pragma unroll
    for (int dd = 0; dd < 8; ++dd) {
        const int d = dg * 8 + dd; const f32x4 r = rr[dd];
        const f32x4 q0 = *(const LAS f32x4*)(qT + d * 8), q1 = *(const LAS f32x4*)(qT + d * 8 + 4);
        const f32x4 z0 = *(const LAS f32x4*)(kzT + d * 8), z1 = *(const LAS f32x4*)(kzT + d * 8 + 4);
        f32x4 rn = r * g8;
#pragma unroll
        for (int i = 0; i < 4; ++i) { pacc[i] += r * q0[i]; pacc[4 + i] += r * q1[i]; rn += vv[i] * z0[i]; rn += vv[4 + i] * z1[i]; }
        *(f32x4*)(Rout + (size_t)d * 128) = rn;
    }
#pragma unroll
    for (int i = 0; i < 8; ++i) {
#pragma unroll
        for (int k = 0; k < 4; ++k) pacc[i][k] += __shfl_xor(pacc[i][k], 32);
        if (lane < 32) *(LAS f32x4*)(po + (w * 8 + i) * 128 + v4) = pacc[i];
    }
    __syncthreads();
    {
        const int i = w, v = lane * 2;
        float o0 = 0.f, o1 = 0.f;
#pragma unroll
        for (int ww = 0; ww < 8; ++ww) { o0 += po[(ww * 8 + i) * 128 + v]; o1 += po[(ww * 8 + i) * 128 + v + 1]; }
        const float xi = __builtin_amdgcn_exp2f((float)(i + 1) * l2g);
        o0 *= xi; o1 *= xi;
#pragma unroll
        for (int j = 0; j < 8; ++j) { const float s = sc[i * 8 + j]; o0 += s * vs[j * 128 + v]; o1 += s * vs[j * 128 + v + 1]; }
        const float mean = wave_sum(o0 + o1) * (1.0f / 128.0f);
        const float d0 = o0 - mean, d1 = o1 - mean;
        const float var = wave_sum(d0 * d0 + d1 * d1) * (1.0f / 128.0f);
        const float rstd = rsqrtf(var + 1e-5f);
        const unsigned gw = *(const unsigned*)(proj + 3 * KS + tokoff(row0 + i, h) + v);
        const float y0 = silu_f(bflo(gw)) * (d0 * rstd * gn_g[h * 128 + v]), y1 = silu_f(bfhi(gw)) * (d1 * rstd * gn_g[h * 128 + v + 1]);
        *(unsigned*)(mix + (size_t)(row0 + i) * DM + h * 128 + v) = cvt_pk_bf16(y0, y1);
    }
    __syncthreads();
}

__device__ __forceinline__ void conv_unit(const bf16* proj, const float* state_conv, const float* conv_w, bf16* mix, float* ncp, float* ncs, int unit, int tid) {
    const int cgp = (tid & 63) * 8, w = tid >> 6;
    const f32x4 w0a = *(const f32x4*)(conv_w + cgp), w0b = *(const f32x4*)(conv_w + cgp + 4);
    const f32x4 w1a = *(const f32x4*)(conv_w + 512 + cgp), w1b = *(const f32x4*)(conv_w + 512 + cgp + 4);
    const f32x4 w2a = *(const f32x4*)(conv_w + 1024 + cgp), w2b = *(const f32x4*)(conv_w + 1024 + cgp + 4);
#pragma unroll
    for (int rr = 0; rr < 4; ++rr) {
        const int m = unit * 32 + w + 8 * rr;
        const bool samp = m >= NPROMPT;
        const int l = samp ? (m & 7) : (m & (SEQ - 1)), bb = samp ? ((m - NPROMPT) >> 3) : (m >> 11);
        const bf16* pr = proj + 4 * KS + (size_t)m * BUW + cgp;
        f32x4 u2a, u2b, ga, gb, u1a, u1b, u0a, u0b;
        unpack8(*(const v4u*)(pr + 512), u2a, u2b);
        unpack8(*(const v4u*)(pr), ga, gb);
        const f32x4 zero = {0.f, 0.f, 0.f, 0.f};
        if (l >= 1) unpack8(*(const v4u*)(pr + 512 - BUW), u1a, u1b);
        else if (samp) { const float* s = state_conv + (size_t)(bb * 2 + 1) * 512 + cgp; u1a = *(const f32x4*)s; u1b = *(const f32x4*)(s + 4); }
        else { u1a = zero; u1b = zero; }
        if (l >= 2) unpack8(*(const v4u*)(pr + 512 - 2 * BUW), u0a, u0b);
        else if (samp) { const float* s = state_conv + (size_t)(bb * 2 + l) * 512 + cgp; u0a = *(const f32x4*)s; u0b = *(const f32x4*)(s + 4); }
        else { u0a = zero; u0b = zero; }
        const f32x4 ya = w0a * u0a + w1a * u1a + w2a * u2a, yb = w0b * u0b + w1b * u1b + w2b * u2b;
        *(v4u*)(mix + (size_t)m * DM + 512 + cgp) = pack8(ga * ya, gb * yb);
        const int L = samp ? 8 : SEQ;
        if (l >= L - 2) { float* d = (samp ? ncs : ncp) + (size_t)(bb * 2 + (l - (L - 2))) * 512 + cgp; *(f32x4*)d = u2a; *(f32x4*)(d + 4) = u2b; }
    }
}

__device__ __forceinline__ unsigned tr_addr16p(unsigned lane, unsigned c, unsigned t) {
    const unsigned g = lane >> 4, q = (lane & 15u) >> 2, p = lane & 3u;
    return off_b(16u * t + 4u * g + q, 2u * c + (p >> 1)) + 8u * (p & 1u);
}
__device__ __forceinline__ void tr_frags4p(unsigned img, unsigned lane, unsigned c, bf16x8 (&f)[4]) {
    const unsigned a0 = img + tr_addr16p(lane, c, 0), a1 = img + tr_addr16p(lane, c, 1);
    s16x4 r0, r1, r2, r3, r4, r5, r6, r7;
    asm volatile("ds_read_b64_tr_b16 %0, %8\n\t"
                 "ds_read_b64_tr_b16 %1, %9\n\t"
                 "ds_read_b64_tr_b16 %2, %8 offset:8192\n\t"
                 "ds_read_b64_tr_b16 %3, %9 offset:8192\n\t"
                 "ds_read_b64_tr_b16 %4, %8 offset:16384\n\t"
                 "ds_read_b64_tr_b16 %5, %9 offset:16384\n\t"
                 "ds_read_b64_tr_b16 %6, %8 offset:24576\n\t"
                 "ds_read_b64_tr_b16 %7, %9 offset:24576\n\t"
                 "s_waitcnt lgkmcnt(0)"
                 : "=&v"(r0), "=&v"(r1), "=&v"(r2), "=&v"(r3), "=&v"(r4), "=&v"(r5), "=&v"(r6), "=&v"(r7)
                 : "v"(a0), "v"(a1) : "memory");
    f[0] = (bf16x8){r0[0], r0[1], r0[2], r0[3], r1[0], r1[1], r1[2], r1[3]};
    f[1] = (bf16x8){r2[0], r2[1], r2[2], r2[3], r3[0], r3[1], r3[2], r3[3]};
    f[2] = (bf16x8){r4[0], r4[1], r4[2], r4[3], r5[0], r5[1], r5[2], r5[3]};
    f[3] = (bf16x8){r6[0], r6[1], r6[2], r6[3], r7[0], r7[1], r7[2], r7[3]};
}
__device__ __forceinline__ void ro_phase(LAS unsigned char* lds, const bf16* proj, const bf16* rs, const float* gn_g, bf16* mix, int bx, int G, int tid) {
    const int lane = tid & 63, w = __builtin_amdgcn_readfirstlane(tid >> 6), fr = lane & 15, fq = lane >> 4;
    LAS unsigned char* Kimg = lds; LAS unsigned char* Vimg = lds + 32768; LAS unsigned char* Rimg = lds + 65536; LAS unsigned char* Stg = lds + 98304 + w * 4096;
    v4u pk[4], pv[4], pr[4]; bf16x8 pq[4];
#define RO_LOAD(unit) do { const int b_ = (unit) >> 6, h_ = ((unit) >> 4) & 3, c_ = (unit) & 15; const bf16* pb_ = proj + ((size_t)((b_ * 4 + h_) * SEQ + c_ * 128)) * 128; \
        _Pragma("unroll") for (int k = 0; k < 4; ++k) { const int id = tid + 512 * k; const bf16* p_ = pb_ + id * 8; \
            pk[k] = *(const v4u*)(p_ + KS); pv[k] = *(const v4u*)(p_ + 2 * KS); pr[k] = *(const v4u*)(rs + (size_t)(unit) * 16384 + id * 8); } \
        _Pragma("unroll") for (int s = 0; s < 4; ++s) pq[s] = *(const bf16x8*)(pb_ + (size_t)(16 * w + fr) * 128 + 32 * s + 8 * fq); } while (0)
    int it = bx;
    if (it < 512) RO_LOAD(it);
    const int tid_o = tid, lane_o = lane;
    for (; it < 512; it += G) {
        int tid = tid_o, lane = lane_o;
        asm volatile("" : "+v"(tid), "+v"(lane));
        const int fr = lane & 15, fq = lane >> 4;
        const int b = it >> 6, h = (it >> 4) & 3, c = it & 15, row0 = b * SEQ + c * 128;
        const float l2g = log2_gamma(h);
#pragma unroll
        for (int k = 0; k < 4; ++k) { const int id = tid + 512 * k, row = id >> 4, ch = id & 15; const unsigned o = off_b(row, ch);
            *(LAS v4u*)(Kimg + o) = pk[k]; *(LAS v4u*)(Vimg + o) = pv[k]; *(LAS v4u*)(Rimg + o) = pr[k]; }
        bf16x8 aQ[4]; v4u gv[4];
#pragma unroll
        for (int s = 0; s < 4; ++s) aQ[s] = pq[s];
#pragma unroll
        for (int k = 0; k < 4; ++k) { const int id = lane + 64 * k; gv[k] = *(const v4u*)(proj + 3 * KS + ((size_t)((b * 4 + h) * SEQ + c * 128 + 16 * w)) * 128 + id * 8); }
        float gg[8];
#pragma unroll
        for (int nb = 0; nb < 8; ++nb) gg[nb] = gn_g[h * 128 + nb * 16 + fr];
        __syncthreads();
        f32x4 accO[8];
        f32x4 xi4;
#pragma unroll
        for (int e = 0; e < 4; ++e) xi4[e] = __builtin_amdgcn_exp2f((float)(16 * w + 4 * fq + e + 1) * l2g);
#pragma unroll
        for (int nb = 0; nb < 8; ++nb) {
            bf16x8 bR[4]; tr_frags4((unsigned)(size_t)Rimg, lane, nb, bR);
            f32x4 a = {0.f, 0.f, 0.f, 0.f};
#pragma unroll
            for (int s = 0; s < 4; ++s) a = MFMA16(aQ[s], bR[s], a);
            accO[nb] = a * xi4;
        }
        const int il = 16 * w + fr;
        bf16x8 aP[4];
#pragma unroll
        for (int s = 0; s < 4; ++s) {
            v4u pw = {0u, 0u, 0u, 0u};
#pragma unroll
            for (int hf = 0; hf < 2; ++hf) {
                const int jb = 2 * s + hf;
                if (jb <= w) {
                    f32x4 a = {0.f, 0.f, 0.f, 0.f};
#pragma unroll
                    for (int s2 = 0; s2 < 4; ++s2) { const bf16x8 kf = *(const LAS bf16x8*)(Kimg + row_addr16(lane, jb, s2)); a = MFMA16(kf, aQ[s2], a); }
                    float p[4];
#pragma unroll
                    for (int e = 0; e < 4; ++e) { const int dlt = il - (16 * jb + 4 * fq + e); p[e] = dlt >= 0 ? a[e] * __builtin_amdgcn_exp2f((float)dlt * l2g) : 0.f; }
                    if (hf == 0) { pw.x = cvt_pk_bf16(p[0], p[1]); pw.y = cvt_pk_bf16(p[2], p[3]); } else { pw.z = cvt_pk_bf16(p[0], p[1]); pw.w = cvt_pk_bf16(p[2], p[3]); }
                }
            }
            aP[s] = __builtin_bit_cast(bf16x8, pw);
        }
        __builtin_amdgcn_sched_barrier(0);
        if (it + G < 512) RO_LOAD(it + G);
        __builtin_amdgcn_sched_barrier(0);
#pragma unroll
        for (int nb = 0; nb < 8; ++nb) {
            bf16x8 bV[4]; tr_frags4p((unsigned)(size_t)Vimg, lane, nb, bV);
            f32x4 a = accO[nb];
#pragma unroll
            for (int s = 0; s < 4; ++s) if (2 * s <= w) a = MFMA16(aP[s], bV[s], a);
            accO[nb] = a;
        }
#pragma unroll
        for (int e = 0; e < 4; ++e) {
            float o[8], sm = 0.f;
#pragma unroll
            for (int nb = 0; nb < 8; ++nb) { o[nb] = accO[nb][e]; sm += o[nb]; }
            sm += __shfl_xor(sm, 1); sm += __shfl_xor(sm, 2); sm += __shfl_xor(sm, 4); sm += __shfl_xor(sm, 8);
            const float mean = sm * (1.0f / 128.0f); float q = 0.f;
#pragma unroll
            for (int nb = 0; nb < 8; ++nb) { o[nb] -= mean; q += o[nb] * o[nb]; }
            q += __shfl_xor(q, 1); q += __shfl_xor(q, 2); q += __shfl_xor(q, 4); q += __shfl_xor(q, 8);
            const float rstd = rsqrtf(q * (1.0f / 128.0f) + 1e-5f);
            const unsigned ro = 4 * fq + e;
#pragma unroll
            for (int nb = 0; nb < 8; ++nb)
                *(LAS unsigned short*)(Stg + off_b(ro, 2 * nb + (fr >> 3)) + 2 * (fr & 7)) = (unsigned short)(cvt_pk_bf16(o[nb] * rstd * gg[nb], 0.f) & 0xffffu);
        }
#pragma unroll
        for (int k = 0; k < 4; ++k) {
            const int id = lane + 64 * k, r = id >> 4, ch = id & 15;
            const v4u ov = *(const LAS v4u*)(Stg + off_b(r, ch));
            f32x4 oa, ob, ga, gb; unpack8(ov, oa, ob); unpack8(gv[k], ga, gb);
            const f32x4 ya = {silu_f(ga[0]) * oa[0], silu_f(ga[1]) * oa[1], silu_f(ga[2]) * oa[2], silu_f(ga[3]) * oa[3]};
            const f32x4 yb = {silu_f(gb[0]) * ob[0], silu_f(gb[1]) * ob[1], silu_f(gb[2]) * ob[2], silu_f(gb[3]) * ob[3]};
            *(v4u*)(mix + (size_t)(row0 + 16 * w + r) * DM + h * 128 + ch * 8) = pack8(ya, yb);
        }
        __syncthreads();
    }
#undef RO_LOAD
}

#define RLX_AGENT __ATOMIC_RELAXED, __HIP_MEMORY_SCOPE_AGENT
#define XB_TMO      128
#define XB_XCNT(j)  (256  + 64 * (j))
#define XB_XSUB(j)  (1280 + 64 * (j))
#define XB_XGEN(j)  (2304 + 64 * (j))
#define XB_TOP      3328
#define XB_TOPGEN   3392
#define XCD_BAR_WORDS 3456
#define XB_SPIN_CAP (1u << 18)

__device__ __forceinline__ unsigned xb_ld(unsigned* p)              { return __hip_atomic_load(p, __ATOMIC_RELAXED, __HIP_MEMORY_SCOPE_AGENT); }
__device__ __forceinline__ unsigned xb_add(unsigned* p, unsigned v) { return __hip_atomic_fetch_add(p, v, __ATOMIC_RELAXED, __HIP_MEMORY_SCOPE_AGENT); }
__device__ __forceinline__ unsigned xb_xcc_id() { return (unsigned)__builtin_amdgcn_s_getreg((3 << 11) | 20) & 0xFu; }
#define XB_SPIN(cond, bar) do { unsigned _sp = 0; while (cond) { __builtin_amdgcn_s_sleep(1); \
    if ((++_sp & 255u) == 0u) { if (xb_ld(&(bar)[XB_TMO])) break; if (_sp > XB_SPIN_CAP) { atomicAdd(&(bar)[XB_TMO], 1u); break; } } } } while (0)

struct XcdBarrier {
    unsigned* bar; unsigned x;
    volatile LAS unsigned* st;
};

__device__ __forceinline__ XcdBarrier xcd_barrier_post(unsigned* bar, volatile LAS unsigned* st) {
    XcdBarrier b; b.bar = bar; b.x = xb_xcc_id(); b.st = st;
    if (threadIdx.x == 0) (void)xb_add(&bar[XB_XCNT(b.x)], 1u);
    return b;
}
__device__ __forceinline__ void xcd_barrier_complete(unsigned* bar, unsigned x, unsigned& nloc, unsigned& nx) {
    const unsigned G = gridDim.x * gridDim.y * gridDim.z;
    unsigned sum, cnt, mine, sp = 0u;
    for (;;) {
        sum = 0u; cnt = 0u; mine = 0u;
#pragma unroll
        for (unsigned j = 0; j < 16; ++j) { const unsigned c = xb_ld(&bar[XB_XCNT(j)]); sum += c; cnt += (c > 0u) ? 1u : 0u; mine = (j == x) ? c : mine; }
        if (sum == G) break;
        __builtin_amdgcn_s_sleep(1);
        if ((++sp & 255u) == 0u) { if (xb_ld(&bar[XB_TMO])) break; if (sp > XB_SPIN_CAP) { atomicAdd(&bar[XB_TMO], 1u); break; } }
    }
    nloc = mine > 0u ? mine : 1u; nx = cnt > 0u ? cnt : 1u;
}

__device__ __forceinline__ void xcd_barrier(const XcdBarrier& b) {
    asm volatile("s_waitcnt vmcnt(0)" ::: "memory");
    __syncthreads();
    if (threadIdx.x == 0) {
        unsigned* bar = b.bar;
        __builtin_amdgcn_s_waitcnt(0);
        unsigned nloc = b.st[0], nx = b.st[1];
        if (nloc == 0u) { xcd_barrier_complete(bar, b.x, nloc, nx); b.st[0] = nloc; b.st[1] = nx; }
        const unsigned old = xb_add(&bar[XB_XSUB(b.x)], 1u);
        const unsigned gen = old / nloc;
        if (old + 1u == (gen + 1u) * nloc) {
            __builtin_amdgcn_fence(__ATOMIC_RELEASE, "agent");
            asm volatile("s_waitcnt vmcnt(0)" ::: "memory");
            const unsigned og = xb_add(&bar[XB_TOP], 1u);
            const unsigned tg = og / nx;
            if (og + 1u == (tg + 1u) * nx) xb_add(&bar[XB_TOPGEN], 1u);
            else XB_SPIN(xb_ld(&bar[XB_TOPGEN]) == tg, bar);
            __builtin_amdgcn_fence(__ATOMIC_ACQUIRE, "agent");
            xb_add(&bar[XB_XGEN(b.x)], 1u);
            asm volatile("s_waitcnt vmcnt(0)" ::: "memory");
        } else {
            XB_SPIN(xb_ld(&bar[XB_XGEN(b.x)]) == gen, bar);
            __builtin_amdgcn_fence(__ATOMIC_ACQUIRE, "agent");
            asm volatile("s_waitcnt vmcnt(0)" ::: "memory");
        }
    }
    __syncthreads();
}

template <int MODE>
__device__ __forceinline__ void small_gemm_unit(LAS unsigned char* lds, const bf16* A, const bf16* Bt, const int K, const int row0, const int col0,
                                                const float* xs, float* io, bf16* h2, const float* g2, float* ss2, int tid) {
    const int lane = tid & 63, w = __builtin_amdgcn_readfirstlane(tid >> 6), fr = lane & 15, fq = lane >> 4;
    const int nks = K >> 5;
    f32x4 acc[2][8];
#pragma unroll
    for (int mb = 0; mb < 2; ++mb)
#pragma unroll
        for (int nb = 0; nb < 8; ++nb) acc[mb][nb] = (f32x4){0.f, 0.f, 0.f, 0.f};
    const bf16* ap = A + (size_t)(row0 + fr) * K + 8 * fq + 32 * w;
    const bf16* bp = Bt + (size_t)(col0 + fr) * K + 8 * fq + 32 * w;
    bf16x8 a[2], b[8];
#pragma unroll
    for (int mb = 0; mb < 2; ++mb) a[mb] = *(const bf16x8*)(ap + (size_t)mb * 16 * K);
#pragma unroll
    for (int nb = 0; nb < 8; ++nb) b[nb] = *(const bf16x8*)(bp + (size_t)nb * 16 * K);
    for (int s = w; s < nks; s += 8) {
        const bool more = (s + 8) < nks;
        bf16x8 an[2], bn[8];
        ap += 256; bp += 256;
        if (more) {
#pragma unroll
            for (int mb = 0; mb < 2; ++mb) an[mb] = *(const bf16x8*)(ap + (size_t)mb * 16 * K);
#pragma unroll
            for (int nb = 0; nb < 8; ++nb) bn[nb] = *(const bf16x8*)(bp + (size_t)nb * 16 * K);
        }
#pragma unroll
        for (int mb = 0; mb < 2; ++mb)
#pragma unroll
            for (int nb = 0; nb < 8; ++nb) acc[mb][nb] = MFMA16(b[nb], a[mb], acc[mb][nb]);
        if (more) {
#pragma unroll
            for (int mb = 0; mb < 2; ++mb) a[mb] = an[mb];
#pragma unroll
            for (int nb = 0; nb < 8; ++nb) b[nb] = bn[nb];
        }
    }
    constexpr int PST = 132;
    LAS float* part = (LAS float*)lds + w * (32 * PST);
#pragma unroll
    for (int mb = 0; mb < 2; ++mb)
#pragma unroll
        for (int nb = 0; nb < 8; ++nb) *(LAS f32x4*)(part + (16 * mb + fr) * PST + 16 * nb + 4 * fq) = acc[mb][nb];
    __syncthreads();
    const int r = tid >> 4, c8 = (tid & 15) * 8;
    f32x4 s0 = {0.f, 0.f, 0.f, 0.f}, s1 = {0.f, 0.f, 0.f, 0.f};
#pragma unroll
    for (int ww = 0; ww < 8; ++ww) { const LAS float* p = (const LAS float*)lds + ww * (32 * PST) + r * PST + c8; s0 += *(const LAS f32x4*)p; s1 += *(const LAS f32x4*)(p + 4); }
    const int row = row0 + r, col = col0 + c8;
    float* o = io + (size_t)row * DM + col;
    if (MODE == 0) {
        const float* xr = xs + (size_t)(row - NPROMPT) * DM + col;
        const f32x4 v0 = s0 + *(const f32x4*)xr, v1 = s1 + *(const f32x4*)(xr + 4);
        *(f32x4*)o = v0; *(f32x4*)(o + 4) = v1;
        float ss = (v0[0] * v0[0] + v0[1] * v0[1]) + (v0[2] * v0[2] + v0[3] * v0[3]) + (v1[0] * v1[0] + v1[1] * v1[1]) + (v1[2] * v1[2] + v1[3] * v1[3]);
        const f32x4 g0 = *(const f32x4*)(g2 + col), g1 = *(const f32x4*)(g2 + col + 4);
        *(v4u*)(h2 + (size_t)row * DM + col) = pack8(v0 * g0, v1 * g1);
        ss += __shfl_xor(ss, 1); ss += __shfl_xor(ss, 2); ss += __shfl_xor(ss, 4); ss += __shfl_xor(ss, 8);
        if ((tid & 15) == 0) { float* sp = ss2 + (size_t)row * 16 + 2 * (col0 >> 7); sp[0] = ss; sp[1] = 0.f; }
    } else {
        const f32x4 v0 = s0 + *(const f32x4*)o, v1 = s1 + *(const f32x4*)(o + 4);
        *(f32x4*)o = v0; *(f32x4*)(o + 4) = v1;
    }
    __syncthreads();
}

__device__ __forceinline__ void p0_transpose_item(const float* W, int K, int N, bf16* WT, int k0, int n0, int dst_row0, LAS float* scr, int lane) {
#pragma unroll 8
    for (int i = 0; i < 32; ++i) { const int kk = 2 * i + (lane >> 5); scr[kk * 33 + (lane & 31)] = W[(size_t)(k0 + kk) * N + n0 + (lane & 31)]; }
    LDS_WAIT(); asm volatile("" ::: "memory");
    const int c = lane & 7;
#pragma unroll
    for (int j = 0; j < 4; ++j) { const int n = (lane >> 3) + 8 * j; const LAS float* s = scr + (8 * c) * 33 + n;
        v4u o; o.x = cvt_pk_bf16(s[0 * 33], s[1 * 33]); o.y = cvt_pk_bf16(s[2 * 33], s[3 * 33]); o.z = cvt_pk_bf16(s[4 * 33], s[5 * 33]); o.w = cvt_pk_bf16(s[6 * 33], s[7 * 33]);
        *(v4u*)(WT + (size_t)(dst_row0 + n) * K + k0 + 8 * c) = o; }
    LDS_WAIT(); asm volatile("" ::: "memory");
}
__device__ __forceinline__ int win_dst(int s) {
    if (s < 1024) { const int sec = s >> 9, hh = (s & 511) >> 7, dpos = s & 127; return (sec * 2 + (hh >> 1)) * 256 + (dpos >> 6) * 128 + (hh & 1) * 64 + (dpos & 63); }
    if (s < 2560) return s;
    if (s < 3072) { const int i = s - 2560; return (10 + (i >> 7)) * 256 + (i & 127); }
    const int i = s - 3072; return (10 + (i >> 7)) * 256 + 128 + (i & 127);
}

struct Args { const float* in[14]; float* out; unsigned char* ws; int lo, hi; };

__global__ void __launch_bounds__(NWAVES * 64, 2) mk_fwd(Args a) {
    extern __shared__ __attribute__((aligned(16))) unsigned char lds_raw[];
    LAS unsigned char* lds = (LAS unsigned char*)lds_raw;
    const int tid = threadIdx.x, lane = tid & 63, wave = __builtin_amdgcn_readfirstlane(tid >> 6);
    const int G = gridDim.x, bx = blockIdx.x;
    const int lo = a.lo, hi = a.hi;
    const float *x_prompt = a.in[0], *x_sample = a.in[1], *state_conv = a.in[2], *state_ret = a.in[3], *norm1_g = a.in[4], *w_in = a.in[5], *conv_w = a.in[6],
                *ret_gn_g = a.in[7], *w_out = a.in[8], *norm2_g = a.in[9], *w_gate = a.in[10], *w_up = a.in[11], *w_down = a.in[12], *norm_f_g = a.in[13];
    unsigned char* ws = a.ws; float* out = a.out;
    bf16* Wt_in = (bf16*)(ws + WS_WIN); bf16* Wt_out = (bf16*)(ws + WS_WOUT); bf16* Wt_gu = (bf16*)(ws + WS_WGU); bf16* Wt_dn = (bf16*)(ws + WS_WDN);
    float* CS = (float*)(ws + WS_CS); float* SS2 = (float*)(ws + WS_SS2);
    bf16* XN = (bf16*)(ws + WS_XN); bf16* PROJ = (bf16*)(ws + WS_PROJ); bf16* ACT = (bf16*)(ws + WS_PROJ);
    float* KV = (float*)(ws + WS_KV); bf16* RS = (bf16*)(ws + WS_RS); bf16* MIX = (bf16*)(ws + WS_MIX);
#define IN(k) (lo <= (k) && (k) < hi)
    XcdBarrier bar; bar.bar = (unsigned*)(ws + WS_CTL); bar.x = 0; bar.st = nullptr;
    if (hi - lo > 1) {
        volatile LAS unsigned* misc = (volatile LAS unsigned*)(lds + MISC_OFF);
        if (tid < 32) misc[tid] = 0u;
        __syncthreads();
        bar = xcd_barrier_post((unsigned*)(ws + WS_CTL), misc + 8);
    }
#define SEAM(k) do { if (IN(k) && IN((k) + 1)) { xcd_barrier(bar); } } while (0)

    if (IN(0)) {
        LAS float* scr = (LAS float*)(lds + wave * 16384);
        const int gw = bx * NWAVES + wave, NGW = G * NWAVES;
        constexpr int I_IN = 16 * (NIN / 32), I_OUT = 16 * 32, I_G = 16 * (FF / 32), I_DN = (FF / 64) * 32;
        constexpr int NITEMS = I_IN + I_OUT + 2 * I_G + I_DN;
        for (int it = gw; it < NITEMS; it += NGW) {
            int r = it;
            if (r < I_IN) { const int kb = r / (NIN / 32), nb = r % (NIN / 32); p0_transpose_item(w_in, DM, NIN, Wt_in, 64 * kb, 32 * nb, win_dst(32 * nb), scr, lane); continue; } r -= I_IN;
            if (r < I_OUT) { const int kb = r / 32, nb = r % 32; p0_transpose_item(w_out, DM, DM, Wt_out, 64 * kb, 32 * nb, 32 * nb, scr, lane); continue; } r -= I_OUT;
            if (r < I_G) { const int kb = r / (FF / 32), nb = r % (FF / 32), s = 32 * nb; p0_transpose_item(w_gate, DM, FF, Wt_gu, 64 * kb, s, (s >> 7) * 256 + (s & 127), scr, lane); continue; } r -= I_G;
            if (r < I_G) { const int kb = r / (FF / 32), nb = r % (FF / 32), s = 32 * nb; p0_transpose_item(w_up, DM, FF, Wt_gu, 64 * kb, s, (s >> 7) * 256 + 128 + (s & 127), scr, lane); continue; } r -= I_G;
            { const int kb = r / 32, nb = r % 32; p0_transpose_item(w_down, FF, DM, Wt_dn, 64 * kb, 32 * nb, 32 * nb, scr, lane); }
        }
        for (int m = gw; m < M; m += NGW) {
            const float* xrow = m < NPROMPT ? x_prompt + (size_t)m * DM : x_sample + (size_t)(m - NPROMPT) * DM;
            const f32x4* xr = (const f32x4*)xrow + lane; f32x4 v[4]; float s = 0.f;
#pragma unroll
            for (int j = 0; j < 4; ++j) { v[j] = xr[64 * j]; s += (v[j][0] * v[j][0] + v[j][1] * v[j][1]) + (v[j][2] * v[j][2] + v[j][3] * v[j][3]); }
            const float r = rsqrtf(wave_sum(s) * (1.0f / DM) + 1e-6f);
            v2u* o8 = (v2u*)(XN + (size_t)m * DM) + lane;
#pragma unroll
            for (int j = 0; j < 4; ++j) { const f32x4 g = ((const f32x4*)norm1_g)[lane + 64 * j]; const f32x4 y = v[j] * r * g; v2u wv; wv.x = cvt_pk_bf16(y[0], y[1]); wv.y = cvt_pk_bf16(y[2], y[3]); o8[64 * j] = wv; }
        }
        for (int e = bx * 512 + tid; e < (SEQ + 8) * 64; e += G * 512) {
            const int p = e >> 6, i = e & 63;
            const double pos = p < SEQ ? (double)p : (double)(16384 + (p - SEQ));
            const double inv = exp2(-(double)i * (13.287712379549449 / 64.0));
            const double rev = pos * inv * 0.15915494309189535;
            const float fr_ = (float)(rev - floor(rev));
            CS[(size_t)p * 128 + i] = __builtin_amdgcn_cosf(fr_); CS[(size_t)p * 128 + 64 + i] = __builtin_amdgcn_sinf(fr_);
        }
    }
    SEAM(0);
    if (IN(1)) {
        pg8::Gemm g{XN, Wt_in, M, NIN, DM}; pg8::StaticOrder S; S.init(M, NIN, G, bx);
        EpiInProj E{PROJ, CS};
        pg8::gemm_phase<EpiInProj, pg8::StaticOrder, true, true>(lds, g, S, E);
    }
    SEAM(1);
    if (IN(2)) {
#ifndef MK_REPK
#define MK_REPK 0
#define MK_REPS 0
#define MK_REPC 0
#endif
        for (int rep = 0; rep <= MK_REPK; ++rep) for (int it = bx; it < 512; it += G) kv_unit(lds, PROJ, KV, it, tid);
        for (int rep = 0; rep <= MK_REPS; ++rep) for (int it = bx; it < 512; it += G) sample_unit(lds, PROJ, state_ret, ret_gn_g, MIX, out + OUT_NRS, it, tid);
        for (int rep = 0; rep <= MK_REPC; ++rep) for (int it = bx; it < M / 32; it += G) conv_unit(PROJ, state_conv, conv_w, MIX, out + OUT_NCP, out + OUT_NCS, it, tid);
    }
    SEAM(2);
    if (IN(3)) {
        for (int e4 = bx * 512 + tid; e4 < 32 * 4096; e4 += G * 512) {
            const int bh = e4 >> 12, dv = (e4 & 4095) * 4, h = bh & 3;
            const float g128 = __builtin_amdgcn_exp2f(128.0f * log2_gamma(h));
            const float* kvp = KV + (size_t)bh * 16 * 16384 + dv; bf16* rp = RS + (size_t)bh * 16 * 16384 + dv;
            f32x4 kvv[16];
#pragma unroll
            for (int c = 0; c < 16; ++c) kvv[c] = *(const f32x4*)(kvp + (size_t)c * 16384);
            f32x4 r = {0.f, 0.f, 0.f, 0.f};
#pragma unroll
            for (int c = 0; c < 16; ++c) { v2u wv; wv.x = cvt_pk_bf16(r[0], r[1]); wv.y = cvt_pk_bf16(r[2], r[3]); *(v2u*)(rp + (size_t)c * 16384) = wv; r = r * g128 + kvv[c]; }
            *(f32x4*)(out + OUT_NRP + (size_t)bh * 16384 + dv) = r;
        }
    }
    SEAM(3);
    if (IN(4)) {
        ro_phase(lds, PROJ, RS, ret_gn_g, MIX, bx, G, tid);
#ifdef MK_REP4
        for (int rep = 0; rep < MK_REP4; ++rep) { xcd_barrier(bar); ro_phase(lds, PROJ, RS, ret_gn_g, MIX, bx, G, tid); }
#endif
    }
    SEAM(4);
    if (IN(5)) {
        pg8::Gemm g{MIX, Wt_out, NPROMPT, DM, DM}; pg8::StaticOrder S; S.init(NPROMPT, DM, G, bx);
        EpiOut E{x_prompt, x_sample, out + OUT_Y, XN, norm2_g, SS2};
        pg8::gemm_phase<EpiOut, pg8::StaticOrder, true, true>(lds, g, S, E);
        for (int it = bx; it < 256; it += G) small_gemm_unit<0>(lds, MIX, Wt_out, DM, NPROMPT + (it >> 3) * 32, (it & 7) * 128, x_sample, out + OUT_Y, XN, norm2_g, SS2, tid);
    }
    SEAM(5);
    if (IN(6)) {
        pg8::Gemm g{XN, Wt_gu, M, NGU, DM}; pg8::StaticOrder S; S.init(M, NGU, G, bx);
        EpiGU E{SS2, ACT};
        pg8::gemm_phase<EpiGU, pg8::StaticOrder, true, true>(lds, g, S, E);
    }
    SEAM(6);
    if (IN(7)) {
        pg8::Gemm g{ACT, Wt_dn, NPROMPT, DM, FF}; pg8::StaticOrder S; S.init(NPROMPT, DM, G, bx);
        EpiDown E{out + OUT_Y};
        pg8::gemm_phase<EpiDown, pg8::StaticOrder, true, true>(lds, g, S, E);
        for (int it = bx; it < 256; it += G) small_gemm_unit<1>(lds, ACT, Wt_dn, FF, NPROMPT + (it >> 3) * 32, (it & 7) * 128, nullptr, out + OUT_Y, nullptr, nullptr, nullptr, tid);
    }
    SEAM(7);
    if (IN(8)) {
        const int gw = bx * NWAVES + wave, NGW = G * NWAVES;
        for (int m = gw; m < M; m += NGW) {
            f32x4* xr = (f32x4*)(out + OUT_Y + (size_t)m * DM) + lane; f32x4 v[4]; float s = 0.f;
#pragma unroll
            for (int j = 0; j < 4; ++j) { v[j] = xr[64 * j]; s += (v[j][0] * v[j][0] + v[j][1] * v[j][1]) + (v[j][2] * v[j][2] + v[j][3] * v[j][3]); }
            const float r = rsqrtf(wave_sum(s) * (1.0f / DM) + 1e-6f);
#pragma unroll
            for (int j = 0; j < 4; ++j) { const f32x4 g = ((const f32x4*)norm_f_g)[lane + 64 * j]; xr[64 * j] = v[j] * r * g; }
        }
    }
#undef IN
#undef SEAM
}

extern "C" void kernel_launch(void* const* d_in, const int* in_sizes, int n_in, void* d_out, int out_size, void* d_ws, size_t ws_size, hipStream_t stream) {
    static int grid = 0;
    if (grid == 0) {
        if (n_in != 14 || ws_size < WS_END) { fprintf(stderr, "kernel_launch: unexpected n_in %d / ws_size %zu\n", n_in, ws_size); grid = -1; return; }
        int dev = 0, cus = 0, per_cu = 0;
        if (hipGetDevice(&dev) != hipSuccess || hipDeviceGetAttribute(&cus, hipDeviceAttributeMultiprocessorCount, dev) != hipSuccess) { grid = -1; return; }
        if (hipFuncSetAttribute((const void*)mk_fwd, hipFuncAttributeMaxDynamicSharedMemorySize, LDS_BYTES) != hipSuccess) { fprintf(stderr, "kernel_launch: hipFuncSetAttribute failed\n"); grid = -1; return; }
        if (hipOccupancyMaxActiveBlocksPerMultiprocessor(&per_cu, (const void*)mk_fwd, NWAVES * 64, LDS_BYTES) != hipSuccess || per_cu < 1) { fprintf(stderr, "kernel_launch: occupancy query gave %d\n", per_cu); (void)hipGetLastError(); per_cu = 1; }
        grid = cus * per_cu;
    }
    if (grid < 0) return;
    if (hipMemsetAsync((char*)d_ws + WS_CTL, 0, CTL_BYTES, stream) != hipSuccess) { fprintf(stderr, "kernel_launch: memset failed\n"); return; }
    Args a{};
    for (int i = 0; i < 14; ++i) a.in[i] = (const float*)d_in[i];
    a.out = (float*)d_out; a.ws = (unsigned char*)d_ws;
#if MK_N_LAUNCHES == 1
    a.lo = 0; a.hi = NPHASE;
    void* args[] = {&a};
    hipError_t e = hipLaunchCooperativeKernel((const void*)mk_fwd, dim3(grid), dim3(NWAVES * 64), args, LDS_BYTES, stream);
    if (e != hipSuccess) fprintf(stderr, "kernel_launch: cooperative launch failed: %s (grid %d)\n", hipGetErrorString(e), grid);
#else
#ifdef MK_PROBE_SEQ
    const int seq[] = MK_PROBE_SEQ;
    for (int p : seq) {
#else
    for (int p = 0; p < NPHASE; ++p) {
#endif
        a.lo = p; a.hi = p + 1;
        hipLaunchKernelGGL(mk_fwd, dim3(grid), dim3(NWAVES * 64), LDS_BYTES, stream, a);
    }
#endif
}
```
